# Optimizing an MI355X kernel written in HIP

```python
import math
import jax, jax.numpy as jnp
from jax import lax
import numpy as np

D_MODEL = 1024
BATCH = 8
SEQ = 2048
DEPTH = 1

GRID_W = 64
CTX_LEN = 256
MIX_W = D_MODEL
F_GROUPS = 4
F_DIM = D_MODEL // 8
FOURIER_W = F_GROUPS * F_DIM
GDN_HEADS = 4
GDN_DK = D_MODEL // 8
GDN_DV = D_MODEL // 8
QK_W = GDN_HEADS * GDN_DK
V_W = GDN_HEADS * GDN_DV
IN_W = FOURIER_W + 2 * QK_W + 2 * V_W + 4 * GDN_HEADS
SHORT_CONV = 3
CHUNK = 64
D_FF = ((8 * D_MODEL // 3 + 127) // 128) * 128
EPS = 1e-6

kernel_name = "hybrid_fourier_gdn_convglu_dit"


def rmsnorm(t, g):
    tf = t.astype(jnp.float32)
    y = tf * lax.rsqrt(jnp.mean(tf * tf, axis=-1, keepdims=True) + EPS)
    return y.astype(t.dtype) * g


def l2norm(t):
    tf = t.astype(jnp.float32)
    return (tf * lax.rsqrt(jnp.sum(tf * tf, axis=-1, keepdims=True) + EPS)).astype(t.dtype)


def modulate(h, shift, scale):
    return h * (1 + scale) + shift


def dwconv1d(t, w):
    k_w = w.shape[0]
    pad = k_w // 2
    length = t.shape[1]
    tp = jnp.pad(t, ((0, 0), (pad, pad), (0, 0)))
    out = tp[:, 0:length] * w[0]
    for j in range(1, k_w):
        out = out + tp[:, j:j + length] * w[j]
    return out


def gated_delta_chunked(q, k, v, beta, g, s0):
    f32 = jnp.float32
    bsz, length, heads, dk = q.shape
    dv = v.shape[-1]
    n_chunks = length // CHUNK

    def chunks(t):
        t = t.astype(f32).reshape(bsz, n_chunks, CHUNK, heads, t.shape[-1])
        return jnp.transpose(t, (1, 0, 3, 2, 4))

    def chunks_s(t):
        t = t.astype(f32).reshape(bsz, n_chunks, CHUNK, heads)
        return jnp.transpose(t, (1, 0, 3, 2))

    qc = chunks(q) * (dk ** -0.5)
    kc = chunks(k)
    vc = chunks(v)
    bc = chunks_s(beta)
    gc = jnp.cumsum(chunks_s(g), axis=-1)
    lower = jnp.tril(jnp.ones((CHUNK, CHUNK), dtype=bool))
    strict = jnp.tril(jnp.ones((CHUNK, CHUNK), dtype=bool), -1)
    diff = gc[..., :, None] - gc[..., None, :]
    decay = jnp.where(lower, jnp.exp(jnp.where(lower, diff, 0.0)), 0.0)

    kb = kc * bc[..., None]
    vb = vc * bc[..., None]
    a_mat = jnp.where(strict, jnp.einsum('nbhid,nbhjd->nbhij', kb, kc) * decay, 0.0)
    eye = jnp.eye(CHUNK, dtype=f32)
    t_inv = lax.linalg.triangular_solve(eye + a_mat, jnp.broadcast_to(eye, a_mat.shape),
                                        left_side=True, lower=True, unit_diagonal=True)
    u_val = jnp.einsum('nbhij,nbhjd->nbhid', t_inv, vb)
    w_key = jnp.einsum('nbhij,nbhjd->nbhid', t_inv, kb * jnp.exp(gc)[..., None])
    attn_intra = jnp.where(lower, jnp.einsum('nbhid,nbhjd->nbhij', qc, kc) * decay, 0.0)
    g_last = gc[..., -1]
    k_dec = kc * jnp.exp(g_last[..., None] - gc)[..., None]
    q_dec = qc * jnp.exp(gc)[..., None]

    def step(s, xs):
        u_i, w_i, a_i, qd_i, kd_i, gl_i = xs
        v_new = u_i - jnp.einsum('bhcd,bhde->bhce', w_i, s)
        o_i = jnp.einsum('bhcd,bhde->bhce', qd_i, s) + jnp.einsum('bhij,bhje->bhie', a_i, v_new)
        s = s * jnp.exp(gl_i)[..., None, None] + jnp.einsum('bhcd,bhce->bhde', kd_i, v_new)
        return s, o_i

    s_final, o = lax.scan(step, s0.astype(f32), (u_val, w_key, attn_intra, q_dec, k_dec, g_last))
    o = jnp.transpose(o, (1, 0, 3, 2, 4)).reshape(bsz, length, heads, dv)
    return o.astype(v.dtype), s_final


def bidir_gdn(q, k, v, beta, g, s0_f, s0_b):
    flip = lambda t: jnp.flip(t, axis=1)
    o_f, s_f = gated_delta_chunked(q, k, v, beta[:, :, 0], g[:, :, 0], s0_f)
    o_b, s_b = gated_delta_chunked(flip(q), flip(k), flip(v), flip(beta[:, :, 1]), flip(g[:, :, 1]), s0_b)
    return o_f + flip(o_b), s_f, s_b


def mixer_inputs(h, w_in_l, conv_l, a_log_l, dt_bias_l):
    bsz, length, _ = h.shape
    p = h @ w_in_l
    o1 = FOURIER_W
    o2 = o1 + 2 * QK_W + V_W
    o3 = o2 + V_W
    u = p[..., :o1]
    qkv = jax.nn.silu(dwconv1d(p[..., o1:o2], conv_l))
    z = p[..., o2:o3]
    ab = p[..., o3:].astype(jnp.float32).reshape(bsz, length, 4, GDN_HEADS)
    q = l2norm(qkv[..., :QK_W].reshape(bsz, length, GDN_HEADS, GDN_DK))
    k = l2norm(qkv[..., QK_W:2 * QK_W].reshape(bsz, length, GDN_HEADS, GDN_DK))
    v = qkv[..., 2 * QK_W:].reshape(bsz, length, GDN_HEADS, GDN_DV)
    beta = jax.nn.sigmoid(ab[:, :, 0:2])
    g = -jnp.exp(a_log_l.astype(jnp.float32)) * jax.nn.softplus(ab[:, :, 2:4] + dt_bias_l.astype(jnp.float32))
    return u, z, q, k, v, beta, g


def fourier_mix(u, w_f):
    bsz, length, _ = u.shape
    ug = u.astype(jnp.float32).reshape(bsz, length, F_GROUPS, F_DIM)
    y = jnp.fft.fft2(ug, axes=(1, 3), norm='ortho').real.astype(u.dtype)
    return jnp.einsum('blgc,gcd->blgd', y, w_f).reshape(bsz, length, FOURIER_W)


def mixer_out(u, o, z, w_f, g_gdn_l, w_out_l):
    bsz, length, _ = z.shape
    y_f = fourier_mix(u, w_f)
    y_d = rmsnorm(o, g_gdn_l) * jax.nn.silu(z).reshape(bsz, length, GDN_HEADS, GDN_DV)
    return jnp.concatenate([y_f, y_d.reshape(bsz, length, V_W)], axis=-1) @ w_out_l


def conv_ffn(h, w_up_l, w_dwc_l, w_down_l, on_grid):
    bsz, length, _ = h.shape
    p = h @ w_up_l
    val, gate = p[..., :D_FF], p[..., D_FF:]
    if on_grid:
        rows = length // GRID_W
        gate = lax.conv_general_dilated(
            gate.reshape(bsz, rows, GRID_W, D_FF), w_dwc_l[:, :, None, :],
            window_strides=(1, 1), padding='SAME',
            dimension_numbers=('NHWC', 'HWIO', 'NHWC'),
            feature_group_count=D_FF).reshape(bsz, length, D_FF)
    else:
        gate = dwconv1d(gate, w_dwc_l[1])
    return (jax.nn.silu(gate) * val) @ w_down_l


def setup_inputs(seed: int = 0) -> dict:
    key = jax.random.key(seed)
    ks = jax.random.split(key, 20)
    f32 = jnp.float32

    def nrm(k, shape, s):
        return jax.random.normal(k, shape, f32) * s

    L = DEPTH
    x = nrm(ks[0], (BATCH, SEQ, D_MODEL), 1.0)
    c = nrm(ks[1], (BATCH, D_MODEL), 1.0)
    ctx = nrm(ks[2], (BATCH, CTX_LEN, D_MODEL), 1.0)
    c_ctx = nrm(ks[3], (D_MODEL,), 1.0)
    w_ada = nrm(ks[4], (L, D_MODEL, 6 * D_MODEL), 0.5 * D_MODEL ** -0.5)
    b_ada = nrm(ks[5], (L, 6 * D_MODEL), 0.02)
    g_pre_mix = 1.0 + nrm(ks[6], (L, D_MODEL), 0.1)
    g_post_mix = 1.0 + nrm(ks[7], (L, D_MODEL), 0.1)
    g_pre_ffn = 1.0 + nrm(ks[8], (L, D_MODEL), 0.1)
    g_post_ffn = 1.0 + nrm(ks[9], (L, D_MODEL), 0.1)
    w_in = nrm(ks[10], (L, D_MODEL, IN_W), D_MODEL ** -0.5)
    w_qkv_conv = nrm(ks[11], (L, SHORT_CONV, 2 * QK_W + V_W), SHORT_CONV ** -0.5)
    a_log = jnp.log(jax.random.uniform(ks[12], (L, 2, GDN_HEADS), f32, minval=1.0, maxval=16.0))
    dt = jnp.exp(jax.random.uniform(ks[13], (L, 2, GDN_HEADS), f32,
                                    minval=math.log(1e-3), maxval=math.log(1e-1)))
    dt_bias = dt + jnp.log(-jnp.expm1(-dt))
    g_gdn = 1.0 + nrm(ks[14], (L, GDN_DV), 0.1)
    w_fourier = nrm(ks[15], (L, F_GROUPS, F_DIM, F_DIM), F_DIM ** -0.5)
    w_out = nrm(ks[16], (L, MIX_W, D_MODEL), MIX_W ** -0.5)
    w_up = nrm(ks[17], (L, D_MODEL, 2 * D_FF), D_MODEL ** -0.5)
    w_dwc = nrm(ks[18], (L, 3, 3, D_FF), 1.0 / 3.0)
    w_down = nrm(ks[19], (L, D_FF, D_MODEL), D_FF ** -0.5)
    return {"x": x, "c": c, "ctx": ctx, "c_ctx": c_ctx, "w_ada": w_ada, "b_ada": b_ada,
            "g_pre_mix": g_pre_mix, "g_post_mix": g_post_mix, "g_pre_ffn": g_pre_ffn,
            "g_post_ffn": g_post_ffn, "w_in": w_in, "w_qkv_conv": w_qkv_conv, "a_log": a_log,
            "dt_bias": dt_bias, "g_gdn": g_gdn, "w_fourier": w_fourier, "w_out": w_out,
            "w_up": w_up, "w_dwc": w_dwc, "w_down": w_down}


def reference(x, c, ctx, c_ctx, w_ada, b_ada, g_pre_mix, g_post_mix, g_pre_ffn, g_post_ffn,
              w_in, w_qkv_conv, a_log, dt_bias, g_gdn, w_fourier, w_out, w_up, w_dwc, w_down):
    xl, xc = x, ctx
    bsz = x.shape[0]
    silu_c = jax.nn.silu(c)
    silu_cc = jax.nn.silu(c_ctx)
    for i in range(DEPTH):
        update_ctx = i < DEPTH - 1
        mod_l = (silu_c @ w_ada[i] + b_ada[i])[:, None, :]
        mod_c = silu_cc @ w_ada[i] + b_ada[i]
        sh1l, sc1l, gt1l, sh2l, sc2l, gt2l = jnp.split(mod_l, 6, axis=-1)
        sh1c, sc1c, gt1c, sh2c, sc2c, gt2c = jnp.split(mod_c, 6, axis=-1)

        hl = modulate(rmsnorm(xl, g_pre_mix[i]), sh1l, sc1l)
        hc = modulate(rmsnorm(xc, g_pre_mix[i]), sh1c, sc1c)
        ul, zl, ql, kl, vl, bl, gl = mixer_inputs(hl, w_in[i], w_qkv_conv[i], a_log[i], dt_bias[i])
        uc, zc, qc, kc, vc, bc, gc = mixer_inputs(hc, w_in[i], w_qkv_conv[i], a_log[i], dt_bias[i])
        s_zero = jnp.zeros((bsz, GDN_HEADS, GDN_DK, GDN_DV), jnp.float32)
        oc, s_f, s_b = bidir_gdn(qc, kc, vc, bc, gc, s_zero, s_zero)
        ol, _, _ = bidir_gdn(ql, kl, vl, bl, gl, s_f, s_b)
        yl = mixer_out(ul, ol, zl, w_fourier[i], g_gdn[i], w_out[i])
        xl = xl + gt1l * rmsnorm(yl, g_post_mix[i])
        if update_ctx:
            yc = mixer_out(uc, oc, zc, w_fourier[i], g_gdn[i], w_out[i])
            xc = xc + gt1c * rmsnorm(yc, g_post_mix[i])

        hl = modulate(rmsnorm(xl, g_pre_ffn[i]), sh2l, sc2l)
        xl = xl + gt2l * rmsnorm(conv_ffn(hl, w_up[i], w_dwc[i], w_down[i], True), g_post_ffn[i])
        if update_ctx:
            hc = modulate(rmsnorm(xc, g_pre_ffn[i]), sh2c, sc2c)
            xc = xc + gt2c * rmsnorm(conv_ffn(hc, w_up[i], w_dwc[i], w_down[i], False), g_post_ffn[i])
    return xl
```

```cpp
#include <hip/hip_runtime.h>
#include <cstdio>
#include <cstdint>
#include <cmath>

namespace nv {
constexpr int D = 1024, BATCH = 8, SEQ = 2048, CTX = 256, TOK = SEQ + CTX;
constexpr int INW = 2576, DFF = 2816, NH = 4, DK = 128;
constexpr float EPS = 1e-6f;

__device__ __forceinline__ float silu_f(float x) { return x / (1.f + expf(-x)); }
__device__ __forceinline__ float sigmoid_f(float x) { return 1.f / (1.f + expf(-x)); }
__device__ __forceinline__ float softplus_f(float x) { return x > 20.f ? x : log1pf(expf(x)); }

__device__ __forceinline__ float block_sum(float v, float* red) {
    for (int o = 32; o > 0; o >>= 1) v += __shfl_xor(v, o);
    const int w = threadIdx.x >> 6, nw = blockDim.x >> 6;
    __syncthreads();
    if ((threadIdx.x & 63) == 0) red[w] = v;
    __syncthreads();
    float s = 0.f;
    for (int i = 0; i < nw; ++i) s += red[i];
    return s;
}

__global__ void k_mod(const float* c, const float* cctx, const float* w_ada, const float* b_ada, float* mod) {
    const int n = blockIdx.x * 256 + threadIdx.x, r = blockIdx.y;
    const float* cv = r < 8 ? c + r * D : cctx;
    float acc = 0.f;
    for (int k = 0; k < D; ++k) acc += silu_f(cv[k]) * w_ada[(size_t)k * 6144 + n];
    mod[r * 6144 + n] = acc + b_ada[n];
}

__global__ void k_normmod(const float* xlat, const float* xctx, const float* g, const float* modl, const float* modc, int shoff, int scoff, float* out) {
    __shared__ float red[8];
    const int row = blockIdx.x;
    const float* in = row < SEQ ? xlat + (size_t)row * D : xctx + (size_t)(row - SEQ) * D;
    const float* mod = row < SEQ ? modl : modc;
    float v[4]; float ss = 0.f;
    for (int i = 0; i < 4; ++i) { v[i] = in[threadIdx.x + 256 * i]; ss += v[i] * v[i]; }
    ss = block_sum(ss, red);
    const float rs = rsqrtf(ss / D + EPS);
    for (int i = 0; i < 4; ++i) { const int cidx = threadIdx.x + 256 * i; out[(size_t)row * D + cidx] = v[i] * rs * g[cidx] * (1.f + mod[scoff + cidx]) + mod[shoff + cidx]; }
}

__global__ void __launch_bounds__(256) k_sgemm(const float* A, int lda, long sA, const float* B, int ldb, long sB, float* C, int ldc, long sC, int M, int N, int K, float alpha, float beta) {
    __shared__ float As[16][64 + 4];
    __shared__ float Bs[16][64 + 4];
    A += sA * blockIdx.z; B += sB * blockIdx.z; C += sC * blockIdx.z;
    const int tx = threadIdx.x & 15, ty = threadIdx.x >> 4;
    const int m0 = blockIdx.y * 64, n0 = blockIdx.x * 64;
    float acc[4][4] = {};
    for (int k0 = 0; k0 < K; k0 += 16) {
        for (int i = 0; i < 4; ++i) { const int e = threadIdx.x + 256 * i; const int r = e >> 4, kk = e & 15; As[kk][r] = A[(size_t)(m0 + r) * lda + k0 + kk]; }
        for (int i = 0; i < 4; ++i) { const int e = threadIdx.x + 256 * i; const int kk = e >> 6, cc = e & 63; Bs[kk][cc] = (n0 + cc < N) ? B[(size_t)(k0 + kk) * ldb + n0 + cc] : 0.f; }
        __syncthreads();
#pragma unroll
        for (int kk = 0; kk < 16; ++kk) {
            float a[4], b[4];
#pragma unroll
            for (int i = 0; i < 4; ++i) { a[i] = As[kk][ty * 4 + i]; b[i] = Bs[kk][tx * 4 + i]; }
#pragma unroll
            for (int i = 0; i < 4; ++i)
#pragma unroll
                for (int j = 0; j < 4; ++j) acc[i][j] += a[i] * b[j];
        }
        __syncthreads();
    }
    for (int i = 0; i < 4; ++i)
        for (int j = 0; j < 4; ++j) { const int r = m0 + ty * 4 + i, cidx = n0 + tx * 4 + j; if (cidx < N) { float* p = C + (size_t)r * ldc + cidx; *p = alpha * acc[i][j] + (beta != 0.f ? beta * *p : 0.f); } }
}

__global__ void k_qkv(const float* P, const float* convw, float* QN, float* KN, float* VV) {
    __shared__ float red[2];
    const int t = blockIdx.x, h = blockIdx.y, d = threadIdx.x;
    const bool lat = t < SEQ; const int lo = lat ? 0 : SEQ, hi = lat ? SEQ : TOK;
    float r[3];
    for (int part = 0; part < 3; ++part) {
        const int ch = part * 512 + h * 128 + d;
        float acc = 0.f;
        for (int j = 0; j < 3; ++j) { const int tt = t + j - 1; if (tt >= lo && tt < hi) acc += P[(size_t)tt * INW + 512 + ch] * convw[j * 1536 + ch]; }
        r[part] = silu_f(acc);
    }
    const float sq = block_sum(r[0] * r[0], red), sk = block_sum(r[1] * r[1], red);
    QN[(size_t)t * 512 + h * 128 + d] = r[0] * rsqrtf(sq + EPS);
    KN[(size_t)t * 512 + h * 128 + d] = r[1] * rsqrtf(sk + EPS);
    VV[(size_t)t * 512 + h * 128 + d] = r[2];
}
__global__ void k_bg(const float* P, const float* a_log, const float* dt_bias, float* BETA, float* G) {
    const int i = blockIdx.x * 256 + threadIdx.x; if (i >= TOK * 8) return;
    const int t = i >> 3, dh = i & 7;
    const float* ab = P + (size_t)t * INW + 2560;
    BETA[i] = sigmoid_f(ab[dh]);
    G[i] = -expf(a_log[dh]) * softplus_f(ab[8 + dh] + dt_bias[dh]);
}
__global__ void __launch_bounds__(128) k_gdn(const float* QN, const float* KN, const float* VV, const float* BETA, const float* G, float* O  ) {
    __shared__ float qs[128], ks[128];
    const int h = blockIdx.x, dir = blockIdx.y, j = threadIdx.x;
    float S[128];
#pragma unroll
    for (int d = 0; d < 128; ++d) S[d] = 0.f;
    const float scale = 0.08838834764831845f;
    for (int step = 0; step < TOK; ++step) {
        int t; bool lat;
        if (step < CTX) { lat = false; t = SEQ + (dir == 0 ? step : CTX - 1 - step); }
        else { lat = true; const int s = step - CTX; t = dir == 0 ? s : SEQ - 1 - s; }
        __syncthreads();
        qs[j] = QN[(size_t)t * 512 + h * 128 + j]; ks[j] = KN[(size_t)t * 512 + h * 128 + j];
        const float v = VV[(size_t)t * 512 + h * 128 + j];
        const float beta = BETA[t * 8 + dir * 4 + h], alpha = expf(G[t * 8 + dir * 4 + h]);
        __syncthreads();
        float kS = 0.f;
#pragma unroll
        for (int d = 0; d < 128; ++d) { S[d] *= alpha; kS += ks[d] * S[d]; }
        const float r = beta * (v - kS);
        float o = 0.f;
#pragma unroll
        for (int d = 0; d < 128; ++d) { S[d] += ks[d] * r; o += qs[d] * S[d]; }
        if (lat) O[((size_t)dir * SEQ + t) * 512 + h * 128 + j] = o * scale;
    }
}
__global__ void k_trig(float* CL, float* SL, float* CC, float* SC) {
    const int i = blockIdx.x * 256 + threadIdx.x;
    if (i < 2048 * 2048) { const int k = i >> 11, l = i & 2047; const int m = (k * l) & 2047; float s, c; sincospif((float)m / 1024.f, &s, &c); CL[i] = c * (1.f / 512.f); SL[i] = s * (1.f / 512.f); }
    if (i < 128 * 128) { const int k = i >> 7, l = i & 127; const int m = (k * l) & 127; float s, c; sincospif((float)m / 64.f, &s, &c); CC[i] = c; SC[i] = s; }
}
__global__ void k_yd(const float* O, const float* P, const float* g_gdn, float* YCAT) {
    __shared__ float red[2];
    const int t = blockIdx.x, h = blockIdx.y, d = threadIdx.x;
    const float o = O[(size_t)t * 512 + h * 128 + d] + O[((size_t)SEQ + t) * 512 + h * 128 + d];
    const float ss = block_sum(o * o, red);
    const float z = P[(size_t)t * INW + 2048 + h * 128 + d];
    YCAT[(size_t)t * 1024 + 512 + h * 128 + d] = o * rsqrtf(ss / 128.f + EPS) * g_gdn[d] * silu_f(z);
}
__global__ void k_res1(const float* x, const float* YL, const float* g_post, const float* g_pre2, const float* modl, float* X1, float* H2) {
    __shared__ float red[8];
    const int row = blockIdx.x;
    float y[4], x1[4]; float ss = 0.f;
    for (int i = 0; i < 4; ++i) { y[i] = YL[(size_t)row * D + threadIdx.x + 256 * i]; ss += y[i] * y[i]; }
    ss = block_sum(ss, red);
    const float rs = rsqrtf(ss / D + EPS);
    float s2 = 0.f;
    for (int i = 0; i < 4; ++i) { const int cidx = threadIdx.x + 256 * i; x1[i] = x[(size_t)row * D + cidx] + modl[2 * D + cidx] * (y[i] * rs * g_post[cidx]); s2 += x1[i] * x1[i]; X1[(size_t)row * D + cidx] = x1[i]; }
    s2 = block_sum(s2, red);
    const float r2 = rsqrtf(s2 / D + EPS);
    for (int i = 0; i < 4; ++i) { const int cidx = threadIdx.x + 256 * i; H2[(size_t)row * D + cidx] = x1[i] * r2 * g_pre2[cidx] * (1.f + modl[4 * D + cidx]) + modl[3 * D + cidx]; }
}
__global__ void k_convgate(const float* P2, const float* wd  , float* ACT) {
    const size_t i = (size_t)blockIdx.x * 256 + threadIdx.x; if (i >= (size_t)SEQ * DFF) return;
    const int t = (int)(i / DFF), c = (int)(i % DFF), y = t >> 6, xx = t & 63;
    float acc = 0.f;
    for (int dy = 0; dy < 3; ++dy) for (int dx = 0; dx < 3; ++dx) { const int yy = y + dy - 1, x2 = xx + dx - 1; if (yy >= 0 && yy < 32 && x2 >= 0 && x2 < 64) acc += P2[(size_t)(yy * 64 + x2) * 5632 + DFF + c] * wd[(dy * 3 + dx) * DFF + c]; }
    ACT[i] = silu_f(acc) * P2[(size_t)t * 5632 + c];
}
__global__ void k_final(const float* X1, const float* F, const float* g_post, const float* modl, float* out) {
    __shared__ float red[8];
    const int row = blockIdx.x;
    float f[4]; float ss = 0.f;
    for (int i = 0; i < 4; ++i) { f[i] = F[(size_t)row * D + threadIdx.x + 256 * i]; ss += f[i] * f[i]; }
    ss = block_sum(ss, red);
    const float rs = rsqrtf(ss / D + EPS);
    for (int i = 0; i < 4; ++i) { const int cidx = threadIdx.x + 256 * i; out[(size_t)row * D + cidx] = X1[(size_t)row * D + cidx] + modl[5 * D + cidx] * (f[i] * rs * g_post[cidx]); }
}

struct Bufs {
    float *MOD, *CL, *SL, *CC, *SC, *H, *P, *QN, *KN, *VV, *BETA, *G, *O, *Z1, *Z2, *Y, *YCAT, *YL, *X1, *H2, *P2, *ACT, *F;
};
inline size_t carve(Bufs& B, float* ws) {
    size_t o = 0; auto take = [&](size_t n) { float* p = ws + o; o += (n + 63) & ~(size_t)63; return p; };
    B.MOD = take(9 * 6144); B.CL = take(2048 * 2048); B.SL = take(2048 * 2048); B.CC = take(128 * 128); B.SC = take(128 * 128);
    B.H = take((size_t)TOK * D); B.P = take((size_t)TOK * INW);
    B.QN = take((size_t)TOK * 512); B.KN = take((size_t)TOK * 512); B.VV = take((size_t)TOK * 512); B.BETA = take(TOK * 8); B.G = take(TOK * 8);
    B.O = take((size_t)2 * SEQ * 512); B.Z1 = take((size_t)SEQ * 512); B.Z2 = take((size_t)SEQ * 512); B.Y = take((size_t)SEQ * 512);
    B.YCAT = take((size_t)SEQ * D); B.YL = take((size_t)SEQ * D); B.X1 = take((size_t)SEQ * D); B.H2 = take((size_t)SEQ * D);
    B.P2 = take((size_t)SEQ * 5632); B.ACT = take((size_t)SEQ * DFF); B.F = take((size_t)SEQ * D);
    return o * 4;
}
inline void sgemm(hipStream_t st, const float* A, int lda, long sA, const float* Bm, int ldb, long sB, float* C, int ldc, long sC, int M, int N, int K, int batch, float alpha = 1.f, float beta = 0.f) {
    dim3 grid((N + 63) / 64, M / 64, batch);
    hipLaunchKernelGGL(k_sgemm, grid, dim3(256), 0, st, A, lda, sA, Bm, ldb, sB, C, ldc, sC, M, N, K, alpha, beta);
}
inline void forward_batch(hipStream_t st, void* const* d_in, const Bufs& B, int b, float* out_b) {
    const float* x = (const float*)d_in[0] + (size_t)b * SEQ * D; const float* ctx = (const float*)d_in[2] + (size_t)b * CTX * D;
    const float *g_pre_mix = (const float*)d_in[6], *g_post_mix = (const float*)d_in[7], *g_pre_ffn = (const float*)d_in[8], *g_post_ffn = (const float*)d_in[9];
    const float *w_in = (const float*)d_in[10], *convw = (const float*)d_in[11], *a_log = (const float*)d_in[12], *dt_bias = (const float*)d_in[13], *g_gdn = (const float*)d_in[14];
    const float *w_f = (const float*)d_in[15], *w_out = (const float*)d_in[16], *w_up = (const float*)d_in[17], *w_dwc = (const float*)d_in[18], *w_down = (const float*)d_in[19];
    const float* modl = B.MOD + b * 6144; const float* modc = B.MOD + 8 * 6144;
    hipLaunchKernelGGL(k_normmod, dim3(TOK), dim3(256), 0, st, x, ctx, g_pre_mix, modl, modc, 0, D, B.H);
    sgemm(st, B.H, D, 0, w_in, INW, 0, B.P, INW, 0, TOK, INW, D, 1);
    hipLaunchKernelGGL(k_qkv, dim3(TOK, 4), dim3(128), 0, st, B.P, convw, B.QN, B.KN, B.VV);
    hipLaunchKernelGGL(k_bg, dim3((TOK * 8 + 255) / 256), dim3(256), 0, st, B.P, a_log, dt_bias, B.BETA, B.G);
    hipLaunchKernelGGL(k_gdn, dim3(4, 2), dim3(128), 0, st, B.QN, B.KN, B.VV, B.BETA, B.G, B.O);
    sgemm(st, B.CL, 2048, 0, B.P, INW, 0, B.Z1, 512, 0, SEQ, 512, 2048, 1);
    sgemm(st, B.SL, 2048, 0, B.P, INW, 0, B.Z2, 512, 0, SEQ, 512, 2048, 1);
    sgemm(st, B.Z1, 512, 128, B.CC, 128, 0, B.Y, 512, 128, SEQ, 128, 128, 4, 1.f, 0.f);
    sgemm(st, B.Z2, 512, 128, B.SC, 128, 0, B.Y, 512, 128, SEQ, 128, 128, 4, -1.f, 1.f);
    sgemm(st, B.Y, 512, 128, w_f, 128, 128 * 128, B.YCAT, 1024, 128, SEQ, 128, 128, 4);
    hipLaunchKernelGGL(k_yd, dim3(SEQ, 4), dim3(128), 0, st, B.O, B.P, g_gdn, B.YCAT);
    sgemm(st, B.YCAT, D, 0, w_out, D, 0, B.YL, D, 0, SEQ, D, D, 1);
    hipLaunchKernelGGL(k_res1, dim3(SEQ), dim3(256), 0, st, x, B.YL, g_post_mix, g_pre_ffn, modl, B.X1, B.H2);
    sgemm(st, B.H2, D, 0, w_up, 5632, 0, B.P2, 5632, 0, SEQ, 5632, D, 1);
    hipLaunchKernelGGL(k_convgate, dim3((SEQ * DFF + 255) / 256), dim3(256), 0, st, B.P2, w_dwc, B.ACT);
    sgemm(st, B.ACT, DFF, 0, w_down, D, 0, B.F, D, 0, SEQ, D, DFF, 1);
    hipLaunchKernelGGL(k_final, dim3(SEQ), dim3(256), 0, st, B.X1, B.F, g_post_ffn, modl, out_b);
}
inline void prologue(hipStream_t st, void* const* d_in, const Bufs& B) {
    hipLaunchKernelGGL(k_mod, dim3(6144 / 256, 9), dim3(256), 0, st, (const float*)d_in[1], (const float*)d_in[3], (const float*)d_in[4], (const float*)d_in[5], B.MOD);
    hipLaunchKernelGGL(k_trig, dim3(2048 * 2048 / 256), dim3(256), 0, st, B.CL, B.SL, B.CC, B.SC);
}
}

#ifndef NAIVE_NO_MAIN
extern "C" void kernel_launch(void* const* d_in, const int* in_sizes, int n_in, void* d_out, int out_size, void* d_ws, size_t ws_size, hipStream_t stream) {
    nv::Bufs B; const size_t need = nv::carve(B, (float*)d_ws);
    if (need > ws_size) { fprintf(stderr, "naive: ws too small: need %zu have %zu\n", need, ws_size); return; }
    nv::prologue(stream, d_in, B);
    for (int b = 0; b < nv::BATCH; ++b) nv::forward_batch(stream, d_in, B, b, (float*)d_out + (size_t)b * nv::SEQ * nv::D);
}
#endif
```

```cpp
#include <hip/hip_runtime.h>
#include <cstdio>
#include <cstdint>

namespace fk {
#define LAS __attribute__((address_space(3)))
#define GAS __attribute__((address_space(1)))
typedef unsigned short bf16_t;
typedef short bf16x8 __attribute__((ext_vector_type(8)));
typedef short s16x4 __attribute__((ext_vector_type(4)));
typedef float f32x4 __attribute__((ext_vector_type(4)));
typedef float f32x2 __attribute__((ext_vector_type(2)));
typedef unsigned u32x4 __attribute__((ext_vector_type(4)));
typedef unsigned u32x2 __attribute__((ext_vector_type(2)));
typedef GAS unsigned gu32;

constexpr int D = 1024, NB = 8, SEQ = 2048, CTX = 256, MLAT = NB * SEQ, MCTX = NB * CTX, MALL = MLAT + MCTX;
constexpr int INW = 2576, DFF = 2816, NUP = 2 * DFF, NH = 4, HD = 128, NCH_L = SEQ / 64, NCH_C = CTX / 64, NCH = NCH_L + NCH_C;
constexpr float EPS = 1e-6f;
constexpr int NWAVES = 8, NTHR = 512;

constexpr size_t MiB = 1u << 20;
constexpr size_t WS_CTL = 0, CTL_BYTES = 1 * MiB;
constexpr size_t WS_MOD = 512 * 1024;
constexpr size_t WS_M12 = 1 * MiB + 512 * 1024;
constexpr size_t WS_AB = 2 * MiB;
constexpr size_t WS_GC = 3 * MiB + 256 * 1024;
constexpr size_t WS_WIN = 4 * MiB, WS_WOUT = 9 * MiB, WS_WUP = 12 * MiB, WS_WDN = 23 * MiB;
constexpr size_t WS_TTAB = 29 * MiB;
constexpr size_t WS_H = 45 * MiB;
constexpr size_t WS_QKV = 81 * MiB;
constexpr size_t WS_Z = 135 * MiB;
constexpr size_t WS_UT = 151 * MiB;
constexpr size_t WS_QNKN = 45 * MiB;
constexpr size_t WS_WU = 167 * MiB;
constexpr size_t WS_ATT = 239 * MiB;
constexpr size_t WS_OFB = 81 * MiB;
constexpr size_t WS_Y = 45 * MiB;
constexpr size_t WS_H2 = 224 * MiB;
constexpr size_t WS_VG = 29 * MiB;
constexpr size_t WS_F = 208 * MiB;
constexpr size_t WS_END = 256 * MiB;
static_assert(WS_WIN + (size_t)2560 * 1024 * 2 <= WS_WOUT && WS_WOUT + (size_t)1024 * 1536 * 2 <= WS_WUP && WS_WUP + (size_t)NUP * 1024 * 2 <= WS_WDN && WS_WDN + (size_t)1024 * DFF * 2 <= WS_TTAB, "weights map");
static_assert(WS_TTAB + (size_t)2 * 2048 * 2048 * 2 <= WS_H && WS_H + (size_t)MALL * 1024 * 2 <= WS_QKV && WS_QKV + (size_t)MALL * 1536 * 2 <= WS_Z && WS_Z + (size_t)MLAT * 512 * 2 <= WS_UT && WS_UT + (size_t)NB * 512 * 2048 * 2 <= WS_WU, "act map");
static_assert(WS_QNKN + (size_t)2 * MALL * 512 * 2 <= WS_QKV && WS_WU + (size_t)NB * NH * NCH * 2 * 32768 <= WS_ATT && WS_ATT + (size_t)NB * NH * NCH_L * 2 * 8192 <= WS_END, "gdn map");
static_assert(WS_OFB + (size_t)2 * MLAT * 512 * 2 <= WS_Z && WS_VG + (size_t)MLAT * NUP * 2 <= WS_F && WS_F + (size_t)MLAT * 1024 * 2 <= WS_END && WS_H2 + (size_t)MLAT * 1024 * 2 <= WS_END, "ffn map");
static_assert(WS_AB + (size_t)MALL * 16 * 4 <= WS_GC && WS_GC + (size_t)NB * NH * NCH * 2 * 64 * 4 <= WS_WIN && WS_MOD + 9 * 6144 * 4 <= CTL_BYTES && WS_M12 + 8 * 128 * 128 * 4 <= WS_AB, "small map");

constexpr int LDS_MISC = 152 * 1024;
constexpr int LDS_BYTES = 153 * 1024;

#define RLX_AGENT __ATOMIC_RELAXED, __HIP_MEMORY_SCOPE_AGENT
#define LDS_WAIT() asm volatile("s_waitcnt lgkmcnt(0)" ::: "memory")
#define VM_WAIT() asm volatile("s_waitcnt vmcnt(0)" ::: "memory")
__device__ __forceinline__ unsigned f2bf(float f) { unsigned u = __builtin_bit_cast(unsigned, f); return (u + 0x7fffu + ((u >> 16) & 1u)) >> 16; }
__device__ __forceinline__ unsigned pk2(float lo, float hi) { return f2bf(lo) | (f2bf(hi) << 16); }
__device__ __forceinline__ float bf2f(unsigned h) { return __builtin_bit_cast(float, h << 16); }
__device__ __forceinline__ float bflo(unsigned w) { return __builtin_bit_cast(float, w << 16); }
__device__ __forceinline__ float bfhi(unsigned w) { return __builtin_bit_cast(float, w & 0xffff0000u); }
__device__ __forceinline__ float wave_sum(float v) {
#pragma unroll
    for (int o = 1; o < 64; o <<= 1) v += __shfl_xor(v, o);
    return v;
}
__device__ __forceinline__ float silu_f(float x) { return x / (1.f + __expf(-x)); }
__device__ __forceinline__ float sigmoid_f(float x) { return 1.f / (1.f + __expf(-x)); }
__device__ __forceinline__ float softplus_f(float x) { return x > 20.f ? x : log1pf(__expf(x)); }

#define XB_TMO      128
#define XB_XCNT(j)  (256  + 64 * (j))
#define XB_XSUB(j)  (1280 + 64 * (j))
#define XB_XGEN(j)  (2304 + 64 * (j))
#define XB_TOP      3328
#define XB_TOPGEN   3392
#define XCD_BAR_WORDS 3456
#define XB_SPIN_CAP (1u << 20)
__device__ __forceinline__ unsigned xb_ld(unsigned* p)              { return __hip_atomic_load(p, __ATOMIC_RELAXED, __HIP_MEMORY_SCOPE_AGENT); }
__device__ __forceinline__ unsigned xb_add(unsigned* p, unsigned v) { return __hip_atomic_fetch_add(p, v, __ATOMIC_RELAXED, __HIP_MEMORY_SCOPE_AGENT); }
__device__ __forceinline__ unsigned xb_xcc_id() { return (unsigned)__builtin_amdgcn_s_getreg((3 << 11) | 20) & 0xFu; }
#define XB_SPIN(cond, bar) do { unsigned _sp = 0; while (cond) { __builtin_amdgcn_s_sleep(1); \
    if ((++_sp & 255u) == 0u) { if (xb_ld(&(bar)[XB_TMO])) break; if (_sp > XB_SPIN_CAP) { atomicAdd(&(bar)[XB_TMO], 1u); break; } } } } while (0)
struct XcdBarrier { unsigned* bar; unsigned x; volatile LAS unsigned* st; };
__device__ __forceinline__ XcdBarrier xcd_barrier_post(unsigned* bar, volatile LAS unsigned* st) {
    XcdBarrier b; b.bar = bar; b.x = xb_xcc_id(); b.st = st;
    if (threadIdx.x == 0) (void)xb_add(&bar[XB_XCNT(b.x)], 1u);
    return b;
}
__device__ __forceinline__ void xcd_barrier_complete(unsigned* bar, unsigned x, unsigned& nloc, unsigned& nx) {
    const unsigned G = gridDim.x * gridDim.y * gridDim.z;
    unsigned sum, cnt, mine, sp = 0u;
    for (;;) {
        sum = 0u; cnt = 0u; mine = 0u;
#pragma unroll
        for (unsigned j = 0; j < 16; ++j) { const unsigned c = xb_ld(&bar[XB_XCNT(j)]); sum += c; cnt += (c > 0u) ? 1u : 0u; mine = (j == x) ? c : mine; }
        if (sum == G) break;
        __builtin_amdgcn_s_sleep(1);
        if ((++sp & 255u) == 0u) { if (xb_ld(&bar[XB_TMO])) break; if (sp > XB_SPIN_CAP) { atomicAdd(&bar[XB_TMO], 1u); break; } }
    }
    nloc = mine > 0u ? mine : 1u; nx = cnt > 0u ? cnt : 1u;
}
__device__ __forceinline__ void xcd_barrier(const XcdBarrier& b) {
    asm volatile("s_waitcnt vmcnt(0)" ::: "memory");
    __syncthreads();
    if (threadIdx.x == 0) {
        unsigned* bar = b.bar;
        __builtin_amdgcn_s_waitcnt(0);
        unsigned nloc = b.st[0], nx = b.st[1];
        if (nloc == 0u) { xcd_barrier_complete(bar, b.x, nloc, nx); b.st[0] = nloc; b.st[1] = nx; }
        const unsigned old = xb_add(&bar[XB_XSUB(b.x)], 1u);
        const unsigned gen = old / nloc;
        if (old + 1u == (gen + 1u) * nloc) {
            __builtin_amdgcn_fence(__ATOMIC_RELEASE, "agent");
            asm volatile("s_waitcnt vmcnt(0)" ::: "memory");
            const unsigned og = xb_add(&bar[XB_TOP], 1u);
            const unsigned tg = og / nx;
            if (og + 1u == (tg + 1u) * nx) xb_add(&bar[XB_TOPGEN], 1u);
            else XB_SPIN(xb_ld(&bar[XB_TOPGEN]) == tg, bar);
            __builtin_amdgcn_fence(__ATOMIC_ACQUIRE, "agent");
            xb_add(&bar[XB_XGEN(b.x)], 1u);
            asm volatile("s_waitcnt vmcnt(0)" ::: "memory");
        } else {
            XB_SPIN(xb_ld(&bar[XB_XGEN(b.x)]) == gen, bar);
            __builtin_amdgcn_fence(__ATOMIC_ACQUIRE, "agent");
            asm volatile("s_waitcnt vmcnt(0)" ::: "memory");
        }
    }
    __syncthreads();
}

namespace pg8 {
constexpr int BM = 256, BK = 64, HALF = 128, HTB = HALF * BK * 2, STAGE_BYTES = 8 * HTB, NXCD = 8;
__device__ __forceinline__ int lds_byte(int r, int c) { const int st = (r >> 4) * 2 + (c >> 5), rr = r & 15, cc = c & 31, ob = rr * 64 + cc * 2; return st * 1024 + (ob ^ (((ob >> 9) & 1) << 5)); }
__device__ __forceinline__ void stage_rc(int b, int& R, int& C) { const int st = b / 1024, sb = b % 1024, swz = sb ^ (((sb >> 9) & 1) << 5); R = (st >> 1) * 16 + swz / 64; C = (st & 1) * 32 + (swz % 64) / 2; }
__device__ __forceinline__ int perm32(int rho) { const int n = rho >> 4, i = rho & 15; return 8 * (i >> 2) + 4 * n + (i & 3); }
__device__ __forceinline__ unsigned cvt_pk_bf16(float lo, float hi) { unsigned r; asm volatile("v_cvt_pk_bf16_f32 %0, %1, %2" : "=v"(r) : "v"(lo), "v"(hi)); return r; }

struct GUnit { const char* A; const char* B; bf16_t* O; int ldc; };

__device__ __forceinline__ int xcd_remap(int L, int nwg) { const int q = nwg / NXCD, r = nwg % NXCD, xcd = L % NXCD, off = L / NXCD; return (xcd < r ? xcd * (q + 1) : r * (q + 1) + (xcd - r) * q) + off; }
__device__ __forceinline__ void tile_of(int id, int nM, int nN, int& pm, int& pn) { const int nig = 8 * nN, gid = id / nig, fm = gid * 8, gsz = (nM - fm) < 8 ? (nM - fm) : 8; pm = fm + ((id % nig) % gsz); pn = (id % nig) / gsz; }

__device__ __forceinline__ void epi_bf16(const f32x4 (&acc)[2][2][4][2], const GUnit& u, int wr, int wc, int fr, int fq) {
    bf16_t* base = u.O + (size_t)(wr * 64 + fr) * u.ldc + wc * 32 + 8 * fq;
#pragma unroll
    for (int ai = 0; ai < 2; ++ai)
#pragma unroll
        for (int m = 0; m < 4; ++m) { bf16_t* rowp = base + (size_t)(ai * HALF + m * 16) * u.ldc;
#pragma unroll
            for (int bj = 0; bj < 2; ++bj) { const f32x4 v0 = acc[ai][bj][m][0], v1 = acc[ai][bj][m][1];
                u32x4 w; w.x = cvt_pk_bf16(v0[0], v0[1]); w.y = cvt_pk_bf16(v0[2], v0[3]); w.z = cvt_pk_bf16(v1[0], v1[1]); w.w = cvt_pk_bf16(v1[2], v1[3]);
                *(u32x4*)(rowp + bj * HALF) = w; } }
}

template <class Sched>
__device__ __forceinline__ void gemm_phase(LAS unsigned char* lds, const int lda, const int ldb, const int K, const Sched& S) {
    const int tid = threadIdx.x, wid = __builtin_amdgcn_readfirstlane(tid >> 6), lane = tid & 63, wr = wid >> 2, wc = wid & 3, fr = lane & 15, fq = lane >> 4;
    const int nt = K / BK;
    unsigned voffA[2], voffB[2];
#pragma unroll
    for (int i = 0; i < 2; ++i) { int R, C; stage_rc(tid * 16 + i * 8192, R, C); const int Rb = (R & ~31) + perm32(R & 31);
        voffA[i] = (unsigned)(R * lda + C) * 2u; voffB[i] = (unsigned)(Rb * ldb + C) * 2u; }
    const size_t kstep = (size_t)(BK * 2);
    const size_t hstepA = (size_t)HALF * lda * 2, hstepB = (size_t)HALF * ldb * 2;
    const unsigned ldsw = (unsigned)wid * 1024u;
    const int aoff = lds_byte(wr * 64 + fr, fq * 8), boff = lds_byte(wc * 32 + fr, fq * 8);
#define PG8_SA(b, h) (((b) * 2 + (h)) * HTB)
#define PG8_SB(b, h) ((4 + (b) * 2 + (h)) * HTB)
#define PG8_STAGE(bufoff, gbase, voff) do { _Pragma("unroll") for (int _i = 0; _i < 2; ++_i) \
        __builtin_amdgcn_global_load_lds((const unsigned*)((const char*)(gbase) + (voff)[_i]), (LAS unsigned*)(lds + (bufoff) + ldsw + _i * 8192), 16, 0, 0); } while (0)
#define PG8_LDA(dst, b, h) do { _Pragma("unroll") for (int m = 0; m < 4; ++m) _Pragma("unroll") for (int k = 0; k < 2; ++k) dst[m][k] = *(const LAS bf16x8*)(lds + PG8_SA(b, h) + aoff + m * 2048 + k * 1024); } while (0)
#define PG8_LDB(dst, b, h) do { _Pragma("unroll") for (int n = 0; n < 2; ++n) _Pragma("unroll") for (int k = 0; k < 2; ++k) dst[n][k] = *(const LAS bf16x8*)(lds + PG8_SB(b, h) + boff + n * 2048 + k * 1024); } while (0)
#define PG8_MMA(ai, bj, At, Bt) do { __builtin_amdgcn_s_setprio(1); _Pragma("unroll") for (int m = 0; m < 4; ++m) _Pragma("unroll") for (int n = 0; n < 2; ++n) _Pragma("unroll") for (int k = 0; k < 2; ++k) \
        acc[ai][bj][m][n] = __builtin_amdgcn_mfma_f32_16x16x32_bf16(Bt[n][k], At[m][k], acc[ai][bj][m][n], 0, 0, 0); __builtin_amdgcn_s_setprio(0); } while (0)
#define PG8_WAIT_V(n) asm volatile("s_waitcnt vmcnt(" #n ")" ::: "memory")
#define PG8_WAIT_L(n) asm volatile("s_waitcnt lgkmcnt(" #n ")" ::: "memory")
#define PG8_BAR __builtin_amdgcn_s_barrier()
#define PG8_SCHED __builtin_amdgcn_sched_barrier(0)
    GUnit cur, nxt; int ui = 0;
    if (!S.next(0, cur)) return;
    f32x4 acc[2][2][4][2];
#pragma unroll
    for (int a = 0; a < 2; ++a)
#pragma unroll
        for (int b = 0; b < 2; ++b)
#pragma unroll
            for (int m = 0; m < 4; ++m)
#pragma unroll
                for (int n = 0; n < 2; ++n) acc[a][b][m][n] = (f32x4){0.f, 0.f, 0.f, 0.f};
    bf16x8 At[4][2], B0[2][2], B1[2][2];
    const char* cA = cur.A; const char* cB = cur.B;
    PG8_STAGE(PG8_SB(0, 0), cB, voffB); PG8_STAGE(PG8_SB(0, 1), cB + hstepB, voffB); PG8_STAGE(PG8_SA(0, 0), cA, voffA); PG8_STAGE(PG8_SA(0, 1), cA + hstepA, voffA);
    if (wr == 1) PG8_BAR;
    PG8_WAIT_V(2); PG8_BAR;
    PG8_STAGE(PG8_SB(1, 0), cB + kstep, voffB); PG8_STAGE(PG8_SA(1, 0), cA + kstep, voffA); PG8_STAGE(PG8_SB(1, 1), cB + hstepB + kstep, voffB);
    PG8_WAIT_V(6); PG8_BAR;
    for (;;) {
        const bool has_next = S.next(ui + 1, nxt);
        const char* nA = has_next ? nxt.A : cA; const char* nB = has_next ? nxt.B : cB;
        for (int t = 0; t < nt; t += 2) {
            const bool last = (t == nt - 2);
            const char* a1 = cA + (size_t)(t + 1) * kstep;
            const char* a2 = last ? nA : cA + (size_t)(t + 2) * kstep; const char* b2 = last ? nB : cB + (size_t)(t + 2) * kstep;
            const char* a3 = a2 + kstep; const char* b3 = b2 + kstep;
            PG8_LDB(B0, 0, 0); PG8_LDB(B1, 0, 1); PG8_SCHED; PG8_LDA(At, 0, 0); PG8_STAGE(PG8_SA(1, 1), a1 + hstepA, voffA);
            PG8_WAIT_V(8); PG8_WAIT_L(0); PG8_BAR; PG8_MMA(0, 0, At, B0); PG8_MMA(0, 1, At, B1); PG8_BAR; PG8_SCHED;
            PG8_LDA(At, 0, 1); PG8_STAGE(PG8_SB(0, 0), b2, voffB); PG8_STAGE(PG8_SB(0, 1), b2 + hstepB, voffB); PG8_STAGE(PG8_SA(0, 0), a2, voffA);
            PG8_WAIT_V(8); PG8_WAIT_L(0); PG8_BAR; PG8_MMA(1, 0, At, B0); PG8_MMA(1, 1, At, B1); PG8_BAR; PG8_SCHED;
            PG8_LDB(B0, 1, 0); PG8_LDB(B1, 1, 1); PG8_SCHED; PG8_LDA(At, 1, 0); PG8_STAGE(PG8_SA(0, 1), a2 + hstepA, voffA);
            PG8_WAIT_V(8); PG8_WAIT_L(0); PG8_BAR; PG8_MMA(0, 0, At, B0); PG8_MMA(0, 1, At, B1); PG8_BAR; PG8_SCHED;
            PG8_LDA(At, 1, 1); PG8_STAGE(PG8_SB(1, 0), b3, voffB); PG8_STAGE(PG8_SB(1, 1), b3 + hstepB, voffB); PG8_STAGE(PG8_SA(1, 0), a3, voffA);
            PG8_WAIT_V(8); PG8_WAIT_L(0); PG8_BAR; PG8_MMA(1, 0, At, B0); PG8_MMA(1, 1, At, B1); PG8_BAR; PG8_SCHED;
        }
        if (wr == 0) PG8_BAR;
        epi_bf16(acc, cur, wr, wc, fr, fq);
        if (!has_next) break;
#pragma unroll
        for (int a = 0; a < 2; ++a)
#pragma unroll
            for (int b = 0; b < 2; ++b)
#pragma unroll
                for (int m = 0; m < 4; ++m)
#pragma unroll
                    for (int n = 0; n < 2; ++n) acc[a][b][m][n] = (f32x4){0.f, 0.f, 0.f, 0.f};
        cur = nxt; cA = nA; cB = nB; ++ui;
        if (wr == 1) PG8_BAR;
    }
    PG8_WAIT_V(0);
    PG8_BAR;
#undef PG8_SA
#undef PG8_SB
#undef PG8_STAGE
#undef PG8_LDA
#undef PG8_LDB
#undef PG8_MMA
#undef PG8_WAIT_V
#undef PG8_WAIT_L
#undef PG8_BAR
#undef PG8_SCHED
}
}

struct Frame {
    LAS unsigned char* lds;
    int tid, lane, wave, vcu, G;
    const float* in[20]; float* out; unsigned char* ws;
};
__device__ __forceinline__ float* ws_f(const Frame& F, size_t off) { return (float*)(F.ws + off); }
__device__ __forceinline__ bf16_t* ws_h(const Frame& F, size_t off) { return (bf16_t*)(F.ws + off); }

__device__ __forceinline__ void p0_transpose_item(const float* W, int ldw, int k0, int n0, bf16_t* WT, int ldwt, int nd0, int kd0, LAS float* scr, int lane) {
#pragma unroll 8
    for (int i = 0; i < 32; ++i) { const int kk = 2 * i + (lane >> 5); scr[kk * 33 + (lane & 31)] = W[(size_t)(k0 + kk) * ldw + n0 + (lane & 31)]; }
    LDS_WAIT(); asm volatile("" ::: "memory");
    const int c = lane & 7;
#pragma unroll
    for (int j = 0; j < 4; ++j) { const int n = (lane >> 3) + 8 * j; const LAS float* s = scr + (8 * c) * 33 + n;
        u32x4 o; o.x = pk2(s[0 * 33], s[1 * 33]); o.y = pk2(s[2 * 33], s[3 * 33]); o.z = pk2(s[4 * 33], s[5 * 33]); o.w = pk2(s[6 * 33], s[7 * 33]);
        *(u32x4*)(WT + (size_t)(nd0 + n) * ldwt + kd0 + 8 * c) = o; }
    LDS_WAIT(); asm volatile("" ::: "memory");
}
__device__ __forceinline__ void p0_prologue(Frame& F) {
    LAS float* scr = (LAS float*)(F.lds + F.wave * 16384);
    const int gw = F.vcu * NWAVES + F.wave, NGW = F.G * NWAVES, lane = F.lane;
    const float *w_in = F.in[10], *w_up = F.in[17], *w_down = F.in[19], *w_out = F.in[16], *w_f = F.in[15], *w_ada = F.in[4], *b_ada = F.in[5];
    constexpr int I_IN = 16 * 80, I_UP = 16 * 176, I_DN = 44 * 32, I_OUT = 8 * 32, I_ADA = 96 * 8, I_M = 1024, I_T = 2048;
    constexpr int NITEMS = I_IN + I_UP + I_DN + I_OUT + I_ADA + I_M + I_T;
    for (int it = gw; it < NITEMS; it += NGW) {
        int r = it;
        if (r < I_IN) { const int kb = r / 80, nb = r % 80; p0_transpose_item(w_in, INW, 64 * kb, 32 * nb, ws_h(F, WS_WIN), 1024, 32 * nb, 64 * kb, scr, lane); continue; } r -= I_IN;
        if (r < I_UP) { const int kb = r / 176, nb = r % 176; p0_transpose_item(w_up, NUP, 64 * kb, 32 * nb, ws_h(F, WS_WUP), 1024, 32 * nb, 64 * kb, scr, lane); continue; } r -= I_UP;
        if (r < I_DN) { const int kb = r / 32, nb = r % 32; p0_transpose_item(w_down, 1024, 64 * kb, 32 * nb, ws_h(F, WS_WDN), DFF, 32 * nb, 64 * kb, scr, lane); continue; } r -= I_DN;
        if (r < I_OUT) { const int kb = r / 32, nb = r % 32; p0_transpose_item(w_out + (size_t)512 * 1024, 1024, 64 * kb, 32 * nb, ws_h(F, WS_WOUT), 1536, 32 * nb, 1024 + 64 * kb, scr, lane); continue; } r -= I_OUT;
        if (r < I_ADA) {
            const int cg = r / 8, kp = r % 8, k0 = kp * 128, n = cg * 64 + lane;
#pragma unroll
            for (int row = 0; row < 9; ++row) { const float* cv = row < 8 ? F.in[1] + row * D : F.in[3];
                scr[row * 128 + lane] = silu_f(cv[k0 + lane]); scr[row * 128 + 64 + lane] = silu_f(cv[k0 + 64 + lane]); }
            LDS_WAIT(); asm volatile("" ::: "memory");
            float acc[9];
#pragma unroll
            for (int row = 0; row < 9; ++row) acc[row] = 0.f;
#pragma unroll 4
            for (int kk = 0; kk < 128; ++kk) { const float wv = w_ada[(size_t)(k0 + kk) * 6144 + n];
#pragma unroll
                for (int row = 0; row < 9; ++row) acc[row] += scr[row * 128 + kk] * wv; }
            const float bias = kp == 0 ? b_ada[n] : 0.f;
            float* mod = ws_f(F, WS_MOD);
#pragma unroll
            for (int row = 0; row < 9; ++row) atomicAdd(mod + row * 6144 + n, acc[row] + bias);
            LDS_WAIT(); asm volatile("" ::: "memory");
            continue; } r -= I_ADA;
        if (r < I_M) {
            const int p = r >> 9, g = (r >> 7) & 3, c = r & 127;
            float a0 = 0.f, a1 = 0.f;
            for (int cp = 0; cp < 128; ++cp) { float s, co; sincospif((float)((c * cp) & 127) * (1.f / 64.f), &s, &co); const float tv = p ? s : co;
                a0 += tv * w_f[(size_t)(g * 128 + cp) * 128 + lane]; a1 += tv * w_f[(size_t)(g * 128 + cp) * 128 + 64 + lane]; }
            float* M = ws_f(F, WS_M12) + (size_t)((p * 4 + g) * 128 + c) * 128;
            M[lane] = a0; M[64 + lane] = a1;
            continue; } r -= I_M;
        {
            const int k = r; bf16_t* tc = ws_h(F, WS_TTAB) + (size_t)k * 2048; bf16_t* ts = tc + (size_t)2048 * 2048;
#pragma unroll
            for (int jj = 0; jj < 4; ++jj) { const int l0 = (jj * 64 + lane) * 8; float cv[8], sv[8];
#pragma unroll
                for (int e = 0; e < 8; ++e) sincospif((float)((k * (l0 + e)) & 2047) * (1.f / 1024.f), &sv[e], &cv[e]);
                u32x4 oc, os; oc.x = pk2(cv[0], cv[1]); oc.y = pk2(cv[2], cv[3]); oc.z = pk2(cv[4], cv[5]); oc.w = pk2(cv[6], cv[7]);
                os.x = pk2(sv[0], sv[1]); os.y = pk2(sv[2], sv[3]); os.z = pk2(sv[4], sv[5]); os.w = pk2(sv[6], sv[7]);
                *(u32x4*)(tc + l0) = oc; *(u32x4*)(ts + l0) = os; }
        }
    }
}

__device__ __forceinline__ void p1_phase(Frame& F) {
    const int gw = F.vcu * NWAVES + F.wave, NGW = F.G * NWAVES, lane = F.lane;
    const float* w_in = F.in[10]; const float* gpre = F.in[6];
    LAS float* wab = (LAS float*)F.lds;
    for (int e = F.tid; e < 1024 * 16; e += NTHR) { const int k = e >> 4, j = e & 15; wab[k * 20 + j] = w_in[(size_t)k * INW + 2560 + j]; }
    __syncthreads();
    const float* mod_all = ws_f(F, WS_MOD);
    bf16_t* H = ws_h(F, WS_H); float* AB = ws_f(F, WS_AB);
    for (int row = gw; row < MALL; row += NGW) {
        const float* src; const float* mod;
        if (row < MLAT) { src = F.in[0] + (size_t)row * D; mod = mod_all + (row / SEQ) * 6144; }
        else { src = F.in[2] + (size_t)(row - MLAT) * D; mod = mod_all + 8 * 6144; }
        f32x4 v[4]; float ss = 0.f;
#pragma unroll
        for (int j = 0; j < 4; ++j) { v[j] = *(const f32x4*)(src + 4 * lane + 256 * j); ss += (v[j].x * v[j].x + v[j].y * v[j].y) + (v[j].z * v[j].z + v[j].w * v[j].w); }
        const float rs = rsqrtf(wave_sum(ss) * (1.f / D) + EPS);
        float acc[16];
#pragma unroll
        for (int i = 0; i < 16; ++i) acc[i] = 0.f;
#pragma unroll
        for (int j = 0; j < 4; ++j) { const int col = 4 * lane + 256 * j;
            const f32x4 g = *(const f32x4*)(gpre + col), sc = *(const f32x4*)(mod + 1024 + col), sh = *(const f32x4*)(mod + col);
            f32x4 h; h.x = v[j].x * rs * g.x * (1.f + sc.x) + sh.x; h.y = v[j].y * rs * g.y * (1.f + sc.y) + sh.y; h.z = v[j].z * rs * g.z * (1.f + sc.z) + sh.z; h.w = v[j].w * rs * g.w * (1.f + sc.w) + sh.w;
            u32x2 o; o.x = pk2(h.x, h.y); o.y = pk2(h.z, h.w);
            *(u32x2*)(H + (size_t)row * D + col) = o;
#pragma unroll
            for (int e = 0; e < 4; ++e) { const float hv = h[e]; const LAS float* wr = wab + (col + e) * 20;
#pragma unroll
                for (int q = 0; q < 4; ++q) { const f32x4 w4 = *(const LAS f32x4*)(wr + 4 * q); acc[4 * q] += hv * w4.x; acc[4 * q + 1] += hv * w4.y; acc[4 * q + 2] += hv * w4.z; acc[4 * q + 3] += hv * w4.w; }
                if (e & 1) asm volatile("" ::: "memory"); }
        }
        {
            float a8[8];
#pragma unroll
            for (int i = 0; i < 8; ++i) { const bool hi = (lane & 32) != 0; const float keep = hi ? acc[8 + i] : acc[i], send = hi ? acc[i] : acc[8 + i]; a8[i] = keep + __shfl_xor(send, 32); }
            float a4[4];
#pragma unroll
            for (int i = 0; i < 4; ++i) { const bool hi = (lane & 16) != 0; const float keep = hi ? a8[4 + i] : a8[i], send = hi ? a8[i] : a8[4 + i]; a4[i] = keep + __shfl_xor(send, 16); }
            float a2[2];
#pragma unroll
            for (int i = 0; i < 2; ++i) { const bool hi = (lane & 8) != 0; const float keep = hi ? a4[2 + i] : a4[i], send = hi ? a4[i] : a4[2 + i]; a2[i] = keep + __shfl_xor(send, 8); }
            float a1; { const bool hi = (lane & 4) != 0; const float keep = hi ? a2[1] : a2[0], send = hi ? a2[0] : a2[1]; a1 = keep + __shfl_xor(send, 4); }
            a1 += __shfl_xor(a1, 2); a1 += __shfl_xor(a1, 1);
            const int colj = ((lane >> 5) & 1) * 8 + ((lane >> 4) & 1) * 4 + ((lane >> 3) & 1) * 2 + ((lane >> 2) & 1);
            if ((lane & 3) == 0) AB[(size_t)row * 16 + colj] = a1;
        }
    }
    __syncthreads();
    {
        const float* w_out = F.in[16]; const float* M = ws_f(F, WS_M12); bf16_t* WT = ws_h(F, WS_WOUT);
        LAS float* mscr = (LAS float*)(F.lds + F.wave * 16384);
        for (int it = gw; it < 512; it += NGW) {
            const int nb = it & 15, cb = (it >> 4) & 3, g = (it >> 6) & 3, p = it >> 8;
            const float* Mb = M + (size_t)((p * 4 + g) * 128 + cb * 32) * 128;
#pragma unroll 4
            for (int e = lane; e < 32 * 128; e += 64) mscr[e] = Mb[e];
            LDS_WAIT(); asm volatile("" ::: "memory");
            float acc[32];
#pragma unroll
            for (int i = 0; i < 32; ++i) acc[i] = 0.f;
            const int n = nb * 64 + lane;
            for (int d = 0; d < 128; ++d) { const float wv = w_out[(size_t)(g * 128 + d) * 1024 + n];
#pragma unroll
                for (int i = 0; i < 32; ++i) acc[i] += mscr[i * 128 + d] * wv; }
            const float sc = (p ? -1.f : 1.f) * (1.f / 512.f);
            bf16_t* dst = WT + (size_t)n * 1536 + p * 512 + g * 128 + cb * 32;
#pragma unroll
            for (int q = 0; q < 4; ++q) { u32x4 o; o.x = pk2(acc[8 * q] * sc, acc[8 * q + 1] * sc); o.y = pk2(acc[8 * q + 2] * sc, acc[8 * q + 3] * sc); o.z = pk2(acc[8 * q + 4] * sc, acc[8 * q + 5] * sc); o.w = pk2(acc[8 * q + 6] * sc, acc[8 * q + 7] * sc);
                *(u32x4*)(dst + 8 * q) = o; }
            LDS_WAIT(); asm volatile("" ::: "memory");
        }
    }
}

struct SchedP2 {
    int G, c; const char* H; const char* Wt; bf16_t* QKV; bf16_t* Z; bf16_t* UT;
    __device__ __forceinline__ bool next(int i, pg8::GUnit& u) const {
        constexpr int NW = 512 + 48 + 128;
        const long L = (long)i * G + c; if (L >= NW) return false;
        int id = pg8::xcd_remap((int)L, NW), pm, pn;
        if (id < 512) { pg8::tile_of(id, 64, 8, pm, pn); u.A = H + (size_t)pm * 256 * 2048; u.B = Wt + (size_t)(512 + pn * 256) * 2048;
            if (pn < 6) { u.O = QKV + (size_t)pm * 256 * 1536 + pn * 256; u.ldc = 1536; } else { u.O = Z + (size_t)pm * 256 * 512 + (pn - 6) * 256; u.ldc = 512; } }
        else if (id < 560) { pg8::tile_of(id - 512, 8, 6, pm, pn); pm += 64; u.A = H + (size_t)pm * 256 * 2048; u.B = Wt + (size_t)(512 + pn * 256) * 2048; u.O = QKV + (size_t)pm * 256 * 1536 + pn * 256; u.ldc = 1536; }
        else { pg8::tile_of(id - 560, 2, 64, pm, pn); u.A = Wt + (size_t)pm * 256 * 2048; u.B = H + (size_t)pn * 256 * 2048; u.O = UT + (size_t)((pn >> 3) * 512 + pm * 256) * 2048 + (pn & 7) * 256; u.ldc = 2048; }
        return true;
    }
};
struct SchedFourier {
    int G, c; const char* T; const char* UT; bf16_t* YA;
    __device__ __forceinline__ bool next(int i, pg8::GUnit& u) const {
        const long L = (long)i * G + c; if (L >= 256) return false;
        const int id = pg8::xcd_remap((int)L, 256); int pm, pn; pg8::tile_of(id & 15, 8, 2, pm, pn); const int pb = id >> 4, p = pb >> 3, b = pb & 7;
        u.A = T + (size_t)p * 2048 * 2048 * 2 + (size_t)pm * 256 * 4096; u.B = UT + (size_t)(b * 512 + pn * 256) * 4096;
        u.O = YA + (size_t)(b * 2048 + pm * 256) * 1536 + p * 512 + pn * 256; u.ldc = 1536; return true;
    }
};
struct SchedPlain {
    int G, c, nM, nN; const char* A; const char* B; bf16_t* O; size_t strA, strB; int ldc;
    __device__ __forceinline__ bool next(int i, pg8::GUnit& u) const {
        const long L = (long)i * G + c; const int nwg = nM * nN; if (L >= nwg) return false;
        int pm, pn; pg8::tile_of(pg8::xcd_remap((int)L, nwg), nM, nN, pm, pn);
        u.A = A + (size_t)pm * strA; u.B = B + (size_t)pn * strB; u.O = O + (size_t)pm * 256 * ldc + pn * 256; u.ldc = ldc; return true;
    }
};

template <int K>
__device__ __forceinline__ f32x4 tile_mma(const LAS bf16_t* Arow, const LAS bf16_t* Brow, int fq, f32x4 acc) {
#pragma unroll
    for (int k0 = 0; k0 < K; k0 += 32) {
        const bf16x8 a = *(const LAS bf16x8*)(Arow + k0 + fq * 8);
        const bf16x8 b = *(const LAS bf16x8*)(Brow + k0 + fq * 8);
        acc = __builtin_amdgcn_mfma_f32_16x16x32_bf16(b, a, acc, 0, 0, 0);
    }
    return acc;
}

constexpr int G1_QS = 0, G1_KS = 17408, G1_VS = 34816, G1_RVT = 52224, G1_RKT = 70656, G1_TM = 89088, G1_AM = 98304, G1_GC = 115712, G1_BETA = 115968;
constexpr float QSCALE = 0.08838834764831845f;
__device__ __forceinline__ void g1_unit(Frame& F, int unit) {
    const int bh = unit / NCH, c = unit % NCH, b = bh >> 2, h = bh & 3, lane = F.lane, wave = F.wave, tid = F.tid, fr = lane & 15, fq = lane >> 4;
    const bool lat = c >= NCH_C;
    const int t0 = lat ? (c - NCH_C) * 64 : c * 64, seqlen = lat ? SEQ : CTX, rowbase = lat ? b * SEQ : MLAT + b * CTX;
    LAS bf16_t* Qs = (LAS bf16_t*)(F.lds + G1_QS); LAS bf16_t* Ks = (LAS bf16_t*)(F.lds + G1_KS); LAS bf16_t* Vs = (LAS bf16_t*)(F.lds + G1_VS);
    LAS bf16_t* RVt = (LAS bf16_t*)(F.lds + G1_RVT); LAS bf16_t* RKt = (LAS bf16_t*)(F.lds + G1_RKT); LAS bf16_t* Tm = (LAS bf16_t*)(F.lds + G1_TM);
    LAS float* Am = (LAS float*)(F.lds + G1_AM); LAS float* gcs = (LAS float*)(F.lds + G1_GC); LAS float* betas = (LAS float*)(F.lds + G1_BETA);
    const bf16_t* QKV = ws_h(F, WS_QKV); const float* convw = F.in[11];
    bf16_t* QN = ws_h(F, WS_QNKN); bf16_t* KN = QN + (size_t)MALL * 512;
    {
        float cw[3][3][2];
#pragma unroll
        for (int j = 0; j < 3; ++j)
#pragma unroll
            for (int p = 0; p < 3; ++p) { const f32x2 w2 = *(const f32x2*)(convw + j * 1536 + p * 512 + h * 128 + 2 * lane); cw[j][p][0] = w2.x; cw[j][p][1] = w2.y; }
#pragma unroll 2
        for (int ii = 0; ii < 8; ++ii) {
            const int i = wave * 8 + ii, t = t0 + i;
            float a[3][2];
#pragma unroll
            for (int p = 0; p < 3; ++p) { a[p][0] = 0.f; a[p][1] = 0.f; }
#pragma unroll
            for (int j = 0; j < 3; ++j) { const int tt = t + j - 1;
                if (tt >= 0 && tt < seqlen) {
#pragma unroll
                    for (int p = 0; p < 3; ++p) { const unsigned xv = *(const unsigned*)(QKV + (size_t)(rowbase + tt) * 1536 + p * 512 + h * 128 + 2 * lane);
                        a[p][0] += bflo(xv) * cw[j][p][0]; a[p][1] += bfhi(xv) * cw[j][p][1]; } } }
#pragma unroll
            for (int p = 0; p < 3; ++p) { a[p][0] = silu_f(a[p][0]); a[p][1] = silu_f(a[p][1]); }
            const float rq = rsqrtf(wave_sum(a[0][0] * a[0][0] + a[0][1] * a[0][1]) + EPS), rk = rsqrtf(wave_sum(a[1][0] * a[1][0] + a[1][1] * a[1][1]) + EPS);
            const unsigned qv = pk2(a[0][0] * rq, a[0][1] * rq), kv = pk2(a[1][0] * rk, a[1][1] * rk), vv = pk2(a[2][0], a[2][1]);
            *(LAS unsigned*)(Qs + i * 136 + 2 * lane) = qv; *(LAS unsigned*)(Ks + i * 136 + 2 * lane) = kv; *(LAS unsigned*)(Vs + i * 136 + 2 * lane) = vv;
            *(unsigned*)(QN + (size_t)(rowbase + t) * 512 + h * 128 + 2 * lane) = qv; *(unsigned*)(KN + (size_t)(rowbase + t) * 512 + h * 128 + 2 * lane) = kv;
        }
    }
    const float* AB = ws_f(F, WS_AB);
    for (int dir = 0; dir < 2; ++dir) {
        const size_t rec = (size_t)(bh * NCH + c) * 2 + dir;
        if (wave == 0) {
            const int row = rowbase + t0 + (dir ? 63 - lane : lane);
            const float be = sigmoid_f(AB[(size_t)row * 16 + dir * 4 + h]);
            float g = -__expf(F.in[12][dir * 4 + h]) * softplus_f(AB[(size_t)row * 16 + 8 + dir * 4 + h] + F.in[13][dir * 4 + h]);
#pragma unroll
            for (int o = 1; o < 64; o <<= 1) { const float tv = __shfl_up(g, o); if (lane >= o) g += tv; }
            gcs[lane] = g; betas[lane] = be;
            ws_f(F, WS_GC)[rec * 64 + lane] = g;
        }
        __syncthreads();
#pragma unroll 1
        for (int q = 0; q < 4; ++q) {
            const int tt = wave * 4 + q, which = tt >> 4, tm = (tt & 15) >> 2, tn = tt & 3;
            if (which == 1 && !lat) continue;
            const int ia = tm * 16 + fr, ib = tn * 16 + fr;
            const LAS bf16_t* Arow = (which ? Qs : Ks) + (dir ? 63 - ia : ia) * 136; const LAS bf16_t* Brow = Ks + (dir ? 63 - ib : ib) * 136;
            const f32x4 r = tile_mma<128>(Arow, Brow, fq, (f32x4){0.f, 0.f, 0.f, 0.f});
            const int i = ia; const float gi = gcs[i];
            if (which == 0) { const float bi = betas[i];
#pragma unroll
                for (int e = 0; e < 4; ++e) { const int j = tn * 16 + 4 * fq + e; Am[i * 68 + j] = (i > j) ? bi * r[e] * __expf(gi - gcs[j]) : 0.f; } }
            else { float o[4];
#pragma unroll
                for (int e = 0; e < 4; ++e) { const int j = tn * 16 + 4 * fq + e; o[e] = (i >= j) ? QSCALE * r[e] * __expf(gi - gcs[j]) : 0.f; }
                const size_t arec = (size_t)(bh * NCH_L + (c - NCH_C)) * 2 + dir;
                u32x2 w; w.x = pk2(o[0], o[1]); w.y = pk2(o[2], o[3]);
                *(u32x2*)(ws_h(F, WS_ATT) + arec * 4096 + i * 64 + tn * 16 + 4 * fq) = w; }
        }
        __syncthreads();
        if (wave == 0) {
            float t[64];
#pragma unroll
            for (int i = 0; i < 64; ++i) t[i] = 0.f;
#pragma unroll
            for (int i = 0; i < 64; ++i) {
                float acc = (lane == i) ? 1.f : 0.f;
#pragma unroll
                for (int jb = 0; jb < (i + 3) / 4; ++jb) { const f32x4 a4 = *(const LAS f32x4*)(Am + i * 68 + 4 * jb);
                    acc -= a4.x * t[4 * jb]; acc -= a4.y * t[4 * jb + 1]; acc -= a4.z * t[4 * jb + 2]; acc -= a4.w * t[4 * jb + 3]; }
                t[i] = acc;
            }
#pragma unroll
            for (int i = 0; i < 64; ++i) Tm[i * 72 + lane] = (bf16_t)f2bf(t[i]);
        } else {
            for (int e = tid - 64; e < 128 * 64; e += NTHR - 64) { const int j = e & 63, d = e >> 6, rj = dir ? 63 - j : j; const float bj = betas[j];
                RVt[d * 72 + j] = (bf16_t)f2bf(bj * bf2f(Vs[rj * 136 + d]));
                RKt[d * 72 + j] = (bf16_t)f2bf(bj * __expf(gcs[j]) * bf2f(Ks[rj * 136 + d])); }
        }
        __syncthreads();
        {
            bf16_t* Wrec = ws_h(F, WS_WU) + rec * 16384; bf16_t* Urec = Wrec + 8192;
#pragma unroll 1
            for (int q = 0; q < 8; ++q) {
                const int tt = wave * 8 + q, which = tt >> 5, tm = (tt & 31) >> 3, tn = tt & 7;
                const f32x4 r = tile_mma<64>(Tm + (tm * 16 + fr) * 72, (which ? RKt : RVt) + (tn * 16 + fr) * 72, fq, (f32x4){0.f, 0.f, 0.f, 0.f});
                u32x2 w; w.x = pk2(r[0], r[1]); w.y = pk2(r[2], r[3]);
                *(u32x2*)((which ? Wrec : Urec) + (tm * 16 + fr) * 128 + tn * 16 + 4 * fq) = w;
            }
        }
        __syncthreads();
    }
}

constexpr int G2_W = 0, G2_Q = 17408, G2_KT = 34816, G2_A = 53248, G2_U = 62464, G2_ST = 78848, G2_VNT = 113664, G2_VN2 = 132096, G2_GC = 150528;
__device__ __forceinline__ void g2_chain(Frame& F, int id) {
    const int bh = id >> 1, dir = id & 1, b = bh >> 2, h = bh & 3, lane = F.lane, wave = F.wave, tid = F.tid, fr = lane & 15, fq = lane >> 4;
    LAS bf16_t* Wl = (LAS bf16_t*)(F.lds + G2_W); LAS bf16_t* Ql = (LAS bf16_t*)(F.lds + G2_Q); LAS bf16_t* Ktl = (LAS bf16_t*)(F.lds + G2_KT); LAS bf16_t* Al = (LAS bf16_t*)(F.lds + G2_A);
    LAS bf16_t* Ul = (LAS bf16_t*)(F.lds + G2_U); LAS bf16_t* Stl = (LAS bf16_t*)(F.lds + G2_ST); LAS bf16_t* VNt = (LAS bf16_t*)(F.lds + G2_VNT); LAS bf16_t* VN2 = (LAS bf16_t*)(F.lds + G2_VN2);
    LAS float* gcl = (LAS float*)(F.lds + G2_GC);
    const bf16_t* QN = ws_h(F, WS_QNKN); const bf16_t* KN = QN + (size_t)MALL * 512;
    bf16_t* Obuf = ws_h(F, WS_OFB) + (size_t)dir * MLAT * 512;
    f32x4 Sacc[8];
#pragma unroll
    for (int q = 0; q < 8; ++q) Sacc[q] = (f32x4){0.f, 0.f, 0.f, 0.f};
    for (int e = tid; e < 128 * 136 / 2; e += NTHR) ((LAS unsigned*)Stl)[e] = 0u;
    u32x4 pw[2], pu[2], pq[2], pk[2], pa; float pg = 0.f;
#define G2_CHUNK(n) ((n) < NCH_C ? (dir ? NCH_C - 1 - (n) : (n)) : NCH_C + (dir ? NCH_L - 1 - ((n) - NCH_C) : (n) - NCH_C))
#define G2_LOAD(n) do { const int c_ = G2_CHUNK(n); const bool lat_ = c_ >= NCH_C; const size_t rec_ = (size_t)(bh * NCH + c_) * 2 + dir; \
        const bf16_t* Wrec_ = ws_h(F, WS_WU) + rec_ * 16384; const int rowb_ = lat_ ? b * SEQ + (c_ - NCH_C) * 64 : MLAT + b * CTX + c_ * 64; \
        _Pragma("unroll") for (int i_ = 0; i_ < 2; ++i_) { const int ch_ = tid + i_ * 512, r_ = ch_ >> 4, c8_ = ch_ & 15; \
            pw[i_] = *(const u32x4*)(Wrec_ + ch_ * 8); pu[i_] = *(const u32x4*)(Wrec_ + 8192 + ch_ * 8); \
            pk[i_] = *(const u32x4*)(KN + (size_t)(rowb_ + r_) * 512 + h * 128 + c8_ * 8); \
            if (lat_) pq[i_] = *(const u32x4*)(QN + (size_t)(rowb_ + r_) * 512 + h * 128 + c8_ * 8); } \
        if (lat_) pa = *(const u32x4*)(ws_h(F, WS_ATT) + ((size_t)(bh * NCH_L + (c_ - NCH_C)) * 2 + dir) * 4096 + tid * 8); \
        if (tid < 64) pg = ws_f(F, WS_GC)[rec_ * 64 + tid]; } while (0)
#define G2_STORE(n) do { const int c_ = G2_CHUNK(n); const bool lat_ = c_ >= NCH_C; \
        _Pragma("unroll") for (int i_ = 0; i_ < 2; ++i_) { const int ch_ = tid + i_ * 512, r_ = ch_ >> 4, c8_ = ch_ & 15, is_ = dir ? 63 - r_ : r_; \
            *(LAS u32x4*)(Wl + r_ * 136 + c8_ * 8) = pw[i_]; *(LAS u32x4*)(Ul + r_ * 128 + c8_ * 8) = pu[i_]; \
            if (lat_) *(LAS u32x4*)(Ql + is_ * 136 + c8_ * 8) = pq[i_]; \
            _Pragma("unroll") for (int e_ = 0; e_ < 4; ++e_) { const unsigned w_ = pk[i_][e_]; Ktl[(c8_ * 8 + 2 * e_) * 72 + is_] = (bf16_t)(w_ & 0xffffu); Ktl[(c8_ * 8 + 2 * e_ + 1) * 72 + is_] = (bf16_t)(w_ >> 16); } } \
        if (lat_) *(LAS u32x4*)(Al + (tid >> 3) * 72 + (tid & 7) * 8) = pa; \
        if (tid < 64) gcl[tid] = pg; } while (0)
    G2_LOAD(0);
    G2_STORE(0);
    __syncthreads();
#pragma unroll 1
    for (int n = 0; n < NCH; ++n) {
        const int c = G2_CHUNK(n); const bool lat = c >= NCH_C;
        if (n + 1 < NCH) G2_LOAD(n + 1);
        const float gl = gcl[63];
#pragma unroll
        for (int q = 0; q < 4; ++q) {
            const int tt = wave * 4 + q, tm = tt >> 3, tn = tt & 7, i = tm * 16 + fr;
            const f32x4 r = tile_mma<128>(Wl + i * 136, Stl + (tn * 16 + fr) * 136, fq, (f32x4){0.f, 0.f, 0.f, 0.f});
            const u32x2 uu = *(const LAS u32x2*)(Ul + i * 128 + tn * 16 + 4 * fq);
            const float sc = __expf(gl - gcl[i]);
            const float v0 = bflo(uu.x) - r[0], v1 = bfhi(uu.x) - r[1], v2 = bflo(uu.y) - r[2], v3 = bfhi(uu.y) - r[3];
            const int dv = tn * 16 + 4 * fq;
            VN2[(dv + 0) * 72 + i] = (bf16_t)f2bf(v0); VN2[(dv + 1) * 72 + i] = (bf16_t)f2bf(v1); VN2[(dv + 2) * 72 + i] = (bf16_t)f2bf(v2); VN2[(dv + 3) * 72 + i] = (bf16_t)f2bf(v3);
            VNt[(dv + 0) * 72 + i] = (bf16_t)f2bf(v0 * sc); VNt[(dv + 1) * 72 + i] = (bf16_t)f2bf(v1 * sc); VNt[(dv + 2) * 72 + i] = (bf16_t)f2bf(v2 * sc); VNt[(dv + 3) * 72 + i] = (bf16_t)f2bf(v3 * sc);
        }
        __syncthreads();
        if (lat) {
#pragma unroll
            for (int q = 0; q < 4; ++q) {
                const int tt = wave * 4 + q, tm = tt >> 3, tn = tt & 7, i = tm * 16 + fr;
                f32x4 r = tile_mma<128>(Ql + i * 136, Stl + (tn * 16 + fr) * 136, fq, (f32x4){0.f, 0.f, 0.f, 0.f});
                const float sc = QSCALE * __expf(gcl[i]);
                r = r * sc;
                r = tile_mma<64>(Al + i * 72, VN2 + (tn * 16 + fr) * 72, fq, r);
                const int tok = (c - NCH_C) * 64 + (dir ? 63 - i : i);
                u32x2 w; w.x = pk2(r[0], r[1]); w.y = pk2(r[2], r[3]);
                *(u32x2*)(Obuf + (size_t)(b * SEQ + tok) * 512 + h * 128 + tn * 16 + 4 * fq) = w;
            }
        }
        {
            const float eg = __expf(gl);
#pragma unroll
            for (int q = 0; q < 8; ++q) Sacc[q] = tile_mma<64>(Ktl + (wave * 16 + fr) * 72, VNt + (q * 16 + fr) * 72, fq, Sacc[q] * eg);
        }
        __syncthreads();
#pragma unroll
        for (int q = 0; q < 8; ++q) {
            const int dk = wave * 16 + fr, dv = q * 16 + 4 * fq;
            Stl[(dv + 0) * 136 + dk] = (bf16_t)f2bf(Sacc[q][0]); Stl[(dv + 1) * 136 + dk] = (bf16_t)f2bf(Sacc[q][1]); Stl[(dv + 2) * 136 + dk] = (bf16_t)f2bf(Sacc[q][2]); Stl[(dv + 3) * 136 + dk] = (bf16_t)f2bf(Sacc[q][3]);
        }
        if (n + 1 < NCH) G2_STORE(n + 1);
        __syncthreads();
    }
#undef G2_CHUNK
#undef G2_LOAD
#undef G2_STORE
}

__device__ __forceinline__ void p5_combine(Frame& F, bf16_t* YA) {
    const int gw = F.vcu * NWAVES + F.wave, NGW = F.G * NWAVES, lane = F.lane;
    const bf16_t* OF = ws_h(F, WS_OFB); const bf16_t* OB = OF + (size_t)MLAT * 512; const bf16_t* Z = ws_h(F, WS_Z); const float* gg = F.in[14];
    const int d0 = (lane & 15) * 8;
    float g8[8];
#pragma unroll
    for (int e = 0; e < 8; ++e) g8[e] = gg[d0 + e];
    for (int row = gw; row < MLAT; row += NGW) {
        const u32x4 a = *(const u32x4*)(OF + (size_t)row * 512 + lane * 8), bq = *(const u32x4*)(OB + (size_t)row * 512 + lane * 8), zq = *(const u32x4*)(Z + (size_t)row * 512 + lane * 8);
        float o[8]; float ss = 0.f;
#pragma unroll
        for (int e = 0; e < 4; ++e) { o[2 * e] = bflo(a[e]) + bflo(bq[e]); o[2 * e + 1] = bfhi(a[e]) + bfhi(bq[e]); ss += o[2 * e] * o[2 * e] + o[2 * e + 1] * o[2 * e + 1]; }
        ss += __shfl_xor(ss, 1); ss += __shfl_xor(ss, 2); ss += __shfl_xor(ss, 4); ss += __shfl_xor(ss, 8);
        const float rs = rsqrtf(ss * (1.f / 128.f) + EPS);
        u32x4 w;
#pragma unroll
        for (int e = 0; e < 4; ++e) { const float z0 = bflo(zq[e]), z1 = bfhi(zq[e]); w[e] = pk2(o[2 * e] * rs * g8[2 * e] * silu_f(z0), o[2 * e + 1] * rs * g8[2 * e + 1] * silu_f(z1)); }
        *(u32x4*)(YA + (size_t)row * 1536 + 1024 + lane * 8) = w;
    }
}

__device__ __forceinline__ void p7_phase(Frame& F) {
    const int gw = F.vcu * NWAVES + F.wave, NGW = F.G * NWAVES, lane = F.lane;
    const bf16_t* Y = ws_h(F, WS_Y); bf16_t* H2 = ws_h(F, WS_H2); const float* gpost = F.in[7]; const float* gpre2 = F.in[8]; const float* mod_all = ws_f(F, WS_MOD);
    for (int row = gw; row < MLAT; row += NGW) {
        const float* mod = mod_all + (row / SEQ) * 6144;
        float y[16]; float ss = 0.f;
#pragma unroll
        for (int j = 0; j < 4; ++j) { const u32x2 yy = *(const u32x2*)(Y + (size_t)row * D + 4 * lane + 256 * j); y[4 * j] = bflo(yy.x); y[4 * j + 1] = bfhi(yy.x); y[4 * j + 2] = bflo(yy.y); y[4 * j + 3] = bfhi(yy.y);
            ss += (y[4 * j] * y[4 * j] + y[4 * j + 1] * y[4 * j + 1]) + (y[4 * j + 2] * y[4 * j + 2] + y[4 * j + 3] * y[4 * j + 3]); }
        const float rs = rsqrtf(wave_sum(ss) * (1.f / D) + EPS);
        f32x4 x1[4]; float s2 = 0.f;
#pragma unroll
        for (int j = 0; j < 4; ++j) { const int col = 4 * lane + 256 * j; const f32x4 xv = *(const f32x4*)(F.in[0] + (size_t)row * D + col), g = *(const f32x4*)(gpost + col), gt = *(const f32x4*)(mod + 2048 + col);
            x1[j].x = xv.x + gt.x * (y[4 * j] * rs * g.x); x1[j].y = xv.y + gt.y * (y[4 * j + 1] * rs * g.y); x1[j].z = xv.z + gt.z * (y[4 * j + 2] * rs * g.z); x1[j].w = xv.w + gt.w * (y[4 * j + 3] * rs * g.w);
            s2 += (x1[j].x * x1[j].x + x1[j].y * x1[j].y) + (x1[j].z * x1[j].z + x1[j].w * x1[j].w);
            *(f32x4*)(F.out + (size_t)row * D + col) = x1[j]; }
        const float r2 = rsqrtf(wave_sum(s2) * (1.f / D) + EPS);
#pragma unroll
        for (int j = 0; j < 4; ++j) { const int col = 4 * lane + 256 * j; const f32x4 g = *(const f32x4*)(gpre2 + col), sc = *(const f32x4*)(mod + 4096 + col), sh = *(const f32x4*)(mod + 3072 + col);
            u32x2 o; o.x = pk2(x1[j].x * r2 * g.x * (1.f + sc.x) + sh.x, x1[j].y * r2 * g.y * (1.f + sc.y) + sh.y); o.y = pk2(x1[j].z * r2 * g.z * (1.f + sc.z) + sh.z, x1[j].w * r2 * g.w * (1.f + sc.w) + sh.w);
            *(u32x2*)(H2 + (size_t)row * D + col) = o; }
    }
}

__device__ __forceinline__ void p9_convgate(Frame& F) {
    bf16_t* VG = ws_h(F, WS_VG); const float* wd = F.in[18];
    const int gt = F.vcu * NTHR + F.tid, NGT = F.G * NTHR;
    constexpr int NCC = DFF / 8;
    for (int it = gt; it < NB * 32 * NCC; it += NGT) {
        const int cc = it % NCC, yy = (it / NCC) & 31, b = it / (NCC * 32), c0 = cc * 8;
        float w[9][8];
#pragma unroll
        for (int tp = 0; tp < 9; ++tp) { const f32x4 w0 = *(const f32x4*)(wd + tp * DFF + c0), w1 = *(const f32x4*)(wd + tp * DFF + c0 + 4); w[tp][0] = w0.x; w[tp][1] = w0.y; w[tp][2] = w0.z; w[tp][3] = w0.w; w[tp][4] = w1.x; w[tp][5] = w1.y; w[tp][6] = w1.z; w[tp][7] = w1.w; }
        bf16_t* base = VG + (size_t)(b * SEQ) * NUP;
        u32x4 win[3][3];
#pragma unroll
        for (int dy = 0; dy < 3; ++dy) { win[dy][0] = (u32x4){0u, 0u, 0u, 0u}; win[dy][1] = (u32x4){0u, 0u, 0u, 0u}; const int y2 = yy + dy - 1;
            win[dy][2] = (y2 >= 0 && y2 < 32) ? *(const u32x4*)(base + (size_t)(y2 * 64) * NUP + DFF + c0) : (u32x4){0u, 0u, 0u, 0u}; }
#pragma unroll 1
        for (int x = 0; x < 64; ++x) {
#pragma unroll
            for (int dy = 0; dy < 3; ++dy) { win[dy][0] = win[dy][1]; win[dy][1] = win[dy][2]; const int y2 = yy + dy - 1;
                win[dy][2] = (x + 1 < 64 && y2 >= 0 && y2 < 32) ? *(const u32x4*)(base + (size_t)(y2 * 64 + x + 1) * NUP + DFF + c0) : (u32x4){0u, 0u, 0u, 0u}; }
            float acc[8];
#pragma unroll
            for (int e = 0; e < 8; ++e) acc[e] = 0.f;
#pragma unroll
            for (int dy = 0; dy < 3; ++dy)
#pragma unroll
                for (int dx = 0; dx < 3; ++dx)
#pragma unroll
                    for (int e = 0; e < 4; ++e) { acc[2 * e] += bflo(win[dy][dx][e]) * w[dy * 3 + dx][2 * e]; acc[2 * e + 1] += bfhi(win[dy][dx][e]) * w[dy * 3 + dx][2 * e + 1]; }
            bf16_t* vp = base + (size_t)(yy * 64 + x) * NUP + c0;
            const u32x4 vv = *(const u32x4*)vp; u32x4 o;
#pragma unroll
            for (int e = 0; e < 4; ++e) o[e] = pk2(silu_f(acc[2 * e]) * bflo(vv[e]), silu_f(acc[2 * e + 1]) * bfhi(vv[e]));
            *(u32x4*)vp = o;
        }
    }
}

__device__ __forceinline__ void p11_final(Frame& F) {
    const int gw = F.vcu * NWAVES + F.wave, NGW = F.G * NWAVES, lane = F.lane;
    const bf16_t* Fb = ws_h(F, WS_F); const float* gpost = F.in[9]; const float* mod_all = ws_f(F, WS_MOD);
    for (int row = gw; row < MLAT; row += NGW) {
        const float* mod = mod_all + (row / SEQ) * 6144;
        float y[16]; float ss = 0.f;
#pragma unroll
        for (int j = 0; j < 4; ++j) { const u32x2 yy = *(const u32x2*)(Fb + (size_t)row * D + 4 * lane + 256 * j); y[4 * j] = bflo(yy.x); y[4 * j + 1] = bfhi(yy.x); y[4 * j + 2] = bflo(yy.y); y[4 * j + 3] = bfhi(yy.y);
            ss += (y[4 * j] * y[4 * j] + y[4 * j + 1] * y[4 * j + 1]) + (y[4 * j + 2] * y[4 * j + 2] + y[4 * j + 3] * y[4 * j + 3]); }
        const float rs = rsqrtf(wave_sum(ss) * (1.f / D) + EPS);
#pragma unroll
        for (int j = 0; j < 4; ++j) { const int col = 4 * lane + 256 * j; float* op = F.out + (size_t)row * D + col; const f32x4 xv = *(const f32x4*)op, g = *(const f32x4*)(gpost + col), gt = *(const f32x4*)(mod + 5120 + col);
            f32x4 o; o.x = xv.x + gt.x * (y[4 * j] * rs * g.x); o.y = xv.y + gt.y * (y[4 * j + 1] * rs * g.y); o.z = xv.z + gt.z * (y[4 * j + 2] * rs * g.z); o.w = xv.w + gt.w * (y[4 * j + 3] * rs * g.w);
            *(f32x4*)op = o; }
    }
}

struct Args { const float* in[20]; float* out; unsigned char* ws; int ph_lo, ph_hi; };
constexpr int CW_BAR = 4096;
static_assert((CW_BAR + XCD_BAR_WORDS) * 4 <= (int)WS_MOD, "ctl map");
constexpr int N_PHASES = 12;

__global__ void __launch_bounds__(NTHR, 2) fwd_kernel(Args args) {
    extern __shared__ __attribute__((aligned(16))) unsigned char lds_raw[];
    Frame F;
    F.lds = (LAS unsigned char*)lds_raw;
    F.tid = threadIdx.x; F.lane = F.tid & 63; F.wave = __builtin_amdgcn_readfirstlane(F.tid >> 6);
    F.G = gridDim.x; { const int bx = blockIdx.x; F.vcu = (F.G % 8 == 0) ? (bx % 8) * (F.G / 8) + bx / 8 : bx; }
#pragma unroll
    for (int i = 0; i < 20; ++i) F.in[i] = args.in[i];
    F.out = args.out; F.ws = args.ws;
    volatile LAS unsigned* MISC = (volatile LAS unsigned*)(F.lds + LDS_MISC);
    if (F.tid < 64) MISC[F.tid] = 0u;
    __syncthreads();
    XcdBarrier bar = xcd_barrier_post((unsigned*)(F.ws + WS_CTL) + CW_BAR, MISC + 8);
    const int lo = args.ph_lo, hi = args.ph_hi;
    const int bx = blockIdx.x;
    bf16_t* YA = (bf16_t*)F.out;
#define IN(k) (lo <= (k) && (k) < hi)
#define SEAM(k) do { if (IN(k) && IN((k) + 1)) xcd_barrier(bar); } while (0)

    if (IN(0)) { p0_prologue(F); } SEAM(0);
    if (IN(1)) { p1_phase(F); } SEAM(1);
    if (IN(2)) {
        SchedP2 S{F.G, bx, (const char*)ws_h(F, WS_H), (const char*)ws_h(F, WS_WIN), ws_h(F, WS_QKV), ws_h(F, WS_Z), ws_h(F, WS_UT)};
        pg8::gemm_phase(F.lds, 1024, 1024, 1024, S);
    } SEAM(2);
    if (IN(3)) {
        for (int u = F.vcu; u < NB * NH * NCH; u += F.G) g1_unit(F, u);
        __syncthreads();
        SchedFourier S{F.G, bx, (const char*)ws_h(F, WS_TTAB), (const char*)ws_h(F, WS_UT), YA};
        pg8::gemm_phase(F.lds, 2048, 2048, 2048, S);
    } SEAM(3);
    if (IN(4)) { if (bx < 64) g2_chain(F, bx); } SEAM(4);
    if (IN(5)) { p5_combine(F, YA); } SEAM(5);
    if (IN(6)) {
        SchedPlain S{F.G, bx, 64, 4, (const char*)YA, (const char*)ws_h(F, WS_WOUT), ws_h(F, WS_Y), (size_t)256 * 1536 * 2, (size_t)256 * 1536 * 2, 1024};
        pg8::gemm_phase(F.lds, 1536, 1536, 1536, S);
    } SEAM(6);
    if (IN(7)) { p7_phase(F); } SEAM(7);
    if (IN(8)) {
        SchedPlain S{F.G, bx, 64, 22, (const char*)ws_h(F, WS_H2), (const char*)ws_h(F, WS_WUP), ws_h(F, WS_VG), (size_t)256 * 1024 * 2, (size_t)256 * 1024 * 2, NUP};
        pg8::gemm_phase(F.lds, 1024, 1024, 1024, S);
    } SEAM(8);
    if (IN(9)) { p9_convgate(F); } SEAM(9);
    if (IN(10)) {
        SchedPlain S{F.G, bx, 64, 4, (const char*)ws_h(F, WS_VG), (const char*)ws_h(F, WS_WDN), ws_h(F, WS_F), (size_t)256 * NUP * 2, (size_t)256 * DFF * 2, 1024};
        pg8::gemm_phase(F.lds, NUP, DFF, DFF, S);
    } SEAM(10);
    if (IN(11)) { p11_final(F); }
#undef IN
#undef SEAM
}
}

static int fk_grid() {
    static int grid = 0;
    if (grid == 0) {
        int dev = 0, cus = 0, per_cu = 0;
        hipGetDevice(&dev);
        hipDeviceGetAttribute(&cus, hipDeviceAttributeMultiprocessorCount, dev);
        if (hipFuncSetAttribute((const void*)fk::fwd_kernel, hipFuncAttributeMaxDynamicSharedMemorySize, fk::LDS_BYTES) != hipSuccess) fprintf(stderr, "kernel_launch: hipFuncSetAttribute failed\n");
        if (hipOccupancyMaxActiveBlocksPerMultiprocessor(&per_cu, (const void*)fk::fwd_kernel, fk::NTHR, fk::LDS_BYTES) != hipSuccess || per_cu < 1) { fprintf(stderr, "kernel_launch: occupancy query says %d\n", per_cu); per_cu = 1; }
        (void)hipGetLastError();
        grid = cus;
        if (grid <= 0) grid = 256;
    }
    return grid;
}
static void fk_launch(void* const* d_in, void* d_out, void* d_ws, hipStream_t stream, int lo, int hi) {
    const int grid = fk_grid();
    fk::Args a{};
    for (int i = 0; i < 20; ++i) a.in[i] = (const float*)d_in[i];
    a.out = (float*)d_out; a.ws = (unsigned char*)d_ws; a.ph_lo = lo; a.ph_hi = hi;
    hipLaunchKernelGGL(fk::fwd_kernel, dim3(grid), dim3(fk::NTHR), fk::LDS_BYTES, stream, a);
    const hipError_t le = hipPeekAtLastError();
    if (le != hipSuccess) fprintf(stderr, "kernel_launch: launch failed: %s\n", hipGetErrorName(le));
}

extern "C" void kernel_launch(void* const* d_in, const int* in_sizes, int n_in, void* d_out, int out_size, void* d_ws, size_t ws_size, hipStream_t stream) {
    if (ws_size < fk::WS_END) { fprintf(stderr, "kernel_launch: workspace too small (%zu)\n", ws_size); return; }
    hipMemsetAsync((char*)d_ws + fk::WS_CTL, 0, fk::CTL_BYTES, stream);
    fk_launch(d_in, d_out, d_ws, stream, 0, fk::N_PHASES);
}
```
